# Optimizing an MI355X kernel written in HIP

```python
import math
import jax, jax.numpy as jnp
from jax import lax
import numpy as np

D_MODEL = 1024
BATCH = 32
SEQ = 256
DEPTH = 2
DEC_BATCH = 8
DEC_SEQ = 1024
PAST_LEN = 256

GRID_W = 64
ROPE_BASE = 10000.0
Q_BLOCK = 128
EPS = 1e-6
H_A = 6
DN_A = 64
DR_A = 32
DV_A = 64
Q_RANK = 384
KV_RANK = 256
H_B = 4
DH_B = 32
DV_B = 64
H_C = 4
DK_C = 48
DV_C = 96
GATE_RANK = 16
GATE_NORM = 16.0
CHUNK = 64
WIDTH_A = H_A * DV_A
WIDTH_B = H_B * DV_B
WIDTH_C = H_C * DV_C
MIX_WIDTH = WIDTH_A + WIDTH_B + WIDTH_C
D_FF = 2816
N_MOD = 9
PROJ_SPLITS = (Q_RANK, KV_RANK, DR_A, H_B * 2 * DH_B, H_B * 2 * DH_B, H_B * DV_B,
               H_C * DK_C, H_C * DK_C, H_C * DV_C, WIDTH_C, GATE_RANK, GATE_RANK)
PROJ_COLS = sum(PROJ_SPLITS)

kernel_name = "hybrid_diffusion_mla_diff_gla_step"


def rmsnorm(x, g):
    xf = x.astype(jnp.float32)
    y = xf * lax.rsqrt(jnp.mean(xf * xf, axis=-1, keepdims=True) + EPS)
    return (y * g.astype(jnp.float32)).astype(x.dtype)


def modulate_norm(x, g, shift, scale):
    return rmsnorm(x, g) * (1 + scale) + shift


def swiglu(u, w13, w2):
    a, b = jnp.split(u @ w13, 2, axis=-1)
    return (jax.nn.silu(a) * b) @ w2


def grid_positions(n):
    n_rows = n // GRID_W
    rows = jnp.repeat(jnp.arange(n_rows), GRID_W)
    cols = jnp.arange(n_rows * GRID_W) % GRID_W
    return rows, cols


def rope_1d(x, pos):
    d = x.shape[-1]
    inv = ROPE_BASE ** (-jnp.arange(0, d, 2, dtype=jnp.float32) / d)
    ang = pos.astype(jnp.float32)[:, None] * inv
    shape = (ang.shape[0],) + (1,) * (x.ndim - 3) + (d // 2,)
    cos = jnp.cos(ang).reshape(shape).astype(x.dtype)
    sin = jnp.sin(ang).reshape(shape).astype(x.dtype)
    x1, x2 = x[..., : d // 2], x[..., d // 2:]
    return jnp.concatenate([x1 * cos - x2 * sin, x1 * sin + x2 * cos], axis=-1)


def axial_rope(x):
    rows, cols = grid_positions(x.shape[1])
    h = x.shape[-1] // 2
    return jnp.concatenate([rope_1d(x[..., :h], rows), rope_1d(x[..., h:], cols)], axis=-1)


def query_blocks(fn, qs):
    b, nq = qs[0].shape[:2]
    nb = nq // Q_BLOCK
    qb = tuple(a.reshape((b, nb, Q_BLOCK) + a.shape[2:]).swapaxes(0, 1) for a in qs)
    out = lax.map(lambda t: fn(*t), qb)
    return out.swapaxes(0, 1).reshape((b, nq) + out.shape[3:])


def mla_attend(q_nope, q_rope, ckv, krope, lp):
    k_nope = jnp.einsum("bkr,rhd->bkhd", ckv, lp["mla_w_uk"].reshape(KV_RANK, H_A, DN_A))
    v = jnp.einsum("bkr,rhd->bkhd", ckv, lp["mla_w_uv"].reshape(KV_RANK, H_A, DV_A))
    scale = (DN_A + DR_A) ** -0.5

    def blk(qn, qr):
        s = jnp.einsum("bqhd,bkhd->bhqk", qn, k_nope) + jnp.einsum("bqhd,bkd->bhqk", qr, krope)
        p = jax.nn.softmax(s.astype(jnp.float32) * scale, axis=-1).astype(v.dtype)
        return jnp.einsum("bhqk,bkhd->bqhd", p, v)

    return query_blocks(blk, (q_nope, q_rope))


def diff_attend(q, k, v, lp, lam_init):
    lam = (jnp.exp(jnp.sum(lp["diff_lq1"].astype(jnp.float32) * lp["diff_lk1"].astype(jnp.float32)))
           - jnp.exp(jnp.sum(lp["diff_lq2"].astype(jnp.float32) * lp["diff_lk2"].astype(jnp.float32)))
           + lam_init)
    scale = DH_B ** -0.5

    def blk(qb):
        s = jnp.einsum("bqhjd,bkhjd->bhjqk", qb, k).astype(jnp.float32) * scale
        p = jax.nn.softmax(s, axis=-1)
        a = p[:, :, 0] - lam * p[:, :, 1]
        return jnp.einsum("bhqk,bkhd->bqhd", a.astype(v.dtype), v)

    return query_blocks(blk, (q,))


def gla_chunk_scan(q, k, v, g, s0):
    b_, n, h, _ = q.shape
    nc = n // CHUNK

    def chunks(a):
        return a.reshape(b_, nc, CHUNK, h, a.shape[-1]).transpose(1, 0, 3, 2, 4).astype(jnp.float32)

    qc, kc, vc, gc = chunks(q), chunks(k), chunks(v), chunks(g)
    bcum = jnp.cumsum(gc, axis=-2)
    blast = bcum[..., -1:, :]
    qe = qc * jnp.exp(bcum)
    ke = kc * jnp.exp(-bcum)
    kd = kc * jnp.exp(blast - bcum)
    mask = jnp.tril(jnp.ones((CHUNK, CHUNK), jnp.float32))
    attn = jnp.einsum("nbhtd,nbhsd->nbhts", qe, ke) * mask
    intra = jnp.einsum("nbhts,nbhsv->nbhtv", attn, vc)
    upd = jnp.einsum("nbhsd,nbhsv->nbhdv", kd, vc)
    decay = jnp.exp(blast[..., 0, :])

    def step(s, inp):
        dec, u = inp
        return dec[..., None] * s + u, s

    s_fin, s_in = lax.scan(step, s0.astype(jnp.float32), (decay, upd))
    o = intra + jnp.einsum("nbhtd,nbhdv->nbhtv", qe, s_in)
    o = o.transpose(1, 0, 3, 2, 4).reshape(b_, n, h, v.shape[-1])
    return o.astype(v.dtype), s_fin.astype(q.dtype)


def gla_bidir(q, k, v, g_f, g_b, s_f0, s_b0):
    o_f, s_f = gla_chunk_scan(q, k, v, g_f, s_f0)
    flip = lambda a: a[:, ::-1]
    o_b, s_b = gla_chunk_scan(flip(q), flip(k), flip(v), flip(g_b), s_b0)
    return o_f + flip(o_b), s_f, s_b


def project(u, lp):
    b_, n, _ = u.shape
    offs = np.cumsum(PROJ_SPLITS)[:-1].tolist()
    (cq, ckv, krope, qb, kb, vb, qc, kc, vc, rc, glf, glb) = jnp.split(u @ lp["w_in"], offs, axis=-1)
    q_a = (rmsnorm(cq, lp["mla_q_norm"]) @ lp["mla_w_uq"]).reshape(b_, n, H_A, DN_A + DR_A)
    g_f = jax.nn.log_sigmoid((glf @ lp["gla_wg_f"] + lp["gla_bg_f"]).astype(jnp.float32)) / GATE_NORM
    g_b = jax.nn.log_sigmoid((glb @ lp["gla_wg_b"] + lp["gla_bg_b"]).astype(jnp.float32)) / GATE_NORM
    return {
        "q_nope": q_a[..., :DN_A], "q_rope": q_a[..., DN_A:],
        "ckv": rmsnorm(ckv, lp["mla_kv_norm"]), "krope": krope,
        "q_b": qb.reshape(b_, n, H_B, 2, DH_B), "k_b": kb.reshape(b_, n, H_B, 2, DH_B),
        "v_b": vb.reshape(b_, n, H_B, DV_B),
        "q_c": qc.reshape(b_, n, H_C, DK_C) * (DK_C ** -0.5), "k_c": kc.reshape(b_, n, H_C, DK_C),
        "v_c": vc.reshape(b_, n, H_C, DV_C), "r_c": rc,
        "g_f": g_f.reshape(b_, n, H_C, DK_C), "g_b": g_b.reshape(b_, n, H_C, DK_C),
    }


def merge_groups(o_a, o_b, o_c, r_c, lp, lam_init):
    b_, n = o_a.shape[:2]
    o_a = rmsnorm(o_a.reshape(b_, n, WIDTH_A), lp["mla_out_norm"])
    o_b = (rmsnorm(o_b, lp["diff_norm"]) * (1.0 - lam_init)).reshape(b_, n, WIDTH_B)
    o_c = rmsnorm(o_c, lp["gla_norm"]).reshape(b_, n, WIDTH_C) * jax.nn.silu(r_c)
    return jnp.concatenate([o_a, o_b, o_c], axis=-1) @ lp["w_out"]


def context_mixer(u, lp, lam_init):
    p = project(u, lp)
    b_, n = u.shape[:2]
    o_a = mla_attend(p["q_nope"], p["q_rope"], p["ckv"], p["krope"], lp)
    o_b = diff_attend(p["q_b"], p["k_b"], p["v_b"], lp, lam_init)
    zeros = jnp.zeros((b_, H_C, DK_C, DV_C), u.dtype)
    o_c, s_f, s_b = gla_bidir(p["q_c"], p["k_c"], p["v_c"], p["g_f"], p["g_b"], zeros, zeros)
    out = merge_groups(o_a, o_b, o_c, p["r_c"], lp, lam_init)
    ctx = (p["ckv"], p["krope"], p["k_b"].reshape(b_, n, H_B, 2 * DH_B), p["v_b"], s_f, s_b)
    return out, ctx


def latent_mixer(u, lp, lam_init, ctx):
    ckv_c, krope_c, kb_c, vb_c, sf_c, sb_c = ctx
    p = project(u, lp)
    q_rope = axial_rope(p["q_rope"])
    krope = axial_rope(p["krope"][:, :, None, :])[:, :, 0]
    o_a = mla_attend(p["q_nope"], q_rope, jnp.concatenate([ckv_c, p["ckv"]], axis=1),
                     jnp.concatenate([krope_c, krope], axis=1), lp)
    k_all = jnp.concatenate([kb_c.reshape(kb_c.shape[:3] + (2, DH_B)), axial_rope(p["k_b"])], axis=1)
    v_all = jnp.concatenate([vb_c, p["v_b"]], axis=1)
    o_b = diff_attend(axial_rope(p["q_b"]), k_all, v_all, lp, lam_init)
    o_c, _, _ = gla_bidir(p["q_c"], p["k_c"], p["v_c"], p["g_f"], p["g_b"], sf_c, sb_c)
    return merge_groups(o_a, o_b, o_c, p["r_c"], lp, lam_init), None


def trunk_layer(x, mod, lp, mixer_fn):
    sh1, sc1, g1, sh2, sc2, g2, sh3, sc3, g3 = jnp.split(mod, N_MOD, axis=-1)
    x = x + 0.5 * g1 * swiglu(modulate_norm(x, lp["norm_ffn1"], sh1, sc1), lp["ffn1_w13"], lp["ffn1_w2"])
    mixed, aux = mixer_fn(modulate_norm(x, lp["norm_mix"], sh2, sc2))
    x = x + g2 * mixed
    x = x + 0.5 * g3 * swiglu(modulate_norm(x, lp["norm_ffn2"], sh3, sc3), lp["ffn2_w13"], lp["ffn2_w2"])
    return x, aux


def setup_inputs(seed: int = 0) -> dict:
    key = jax.random.key(seed)
    ks = iter(jax.random.split(key, 48))

    def nrm(shape, scale):
        return jax.random.normal(next(ks), shape, jnp.float32) * scale

    def gain(shape):
        return 1.0 + nrm(shape, 0.05)

    L, D = DEPTH, D_MODEL
    return {
        "x_prompt": nrm((BATCH, SEQ, D), 1.0),
        "x_sample": nrm((DEC_BATCH, DEC_SEQ, D), 1.0),
        "cache_mla_ckv": nrm((DEC_BATCH, L, PAST_LEN, KV_RANK), 1.0),
        "cache_mla_krope": nrm((DEC_BATCH, L, PAST_LEN, DR_A), 1.0),
        "cache_diff_k": nrm((DEC_BATCH, L, PAST_LEN, H_B, 2 * DH_B), 1.0),
        "cache_diff_v": nrm((DEC_BATCH, L, PAST_LEN, H_B, DV_B), 1.0),
        "state_gla_fwd": nrm((DEC_BATCH, L, H_C, DK_C, DV_C), 0.5),
        "state_gla_bwd": nrm((DEC_BATCH, L, H_C, DK_C, DV_C), 0.5),
        "c": nrm((DEC_BATCH, D), 1.0),
        "c_ctx": nrm((D,), 1.0),
        "w_mod": nrm((L, D, N_MOD * D), 0.5 * D ** -0.5),
        "b_mod": nrm((L, N_MOD * D), 0.02),
        "norm_ffn1": gain((L, D)),
        "ffn1_w13": nrm((L, D, 2 * D_FF), D ** -0.5),
        "ffn1_w2": nrm((L, D_FF, D), D_FF ** -0.5),
        "norm_mix": gain((L, D)),
        "w_in": nrm((L, D, PROJ_COLS), D ** -0.5),
        "mla_q_norm": gain((L, Q_RANK)),
        "mla_w_uq": nrm((L, Q_RANK, H_A * (DN_A + DR_A)), Q_RANK ** -0.5),
        "mla_kv_norm": gain((L, KV_RANK)),
        "mla_w_uk": nrm((L, KV_RANK, H_A * DN_A), KV_RANK ** -0.5),
        "mla_w_uv": nrm((L, KV_RANK, H_A * DV_A), KV_RANK ** -0.5),
        "mla_out_norm": gain((L, WIDTH_A)),
        "diff_lq1": nrm((L, DH_B), 0.1),
        "diff_lk1": nrm((L, DH_B), 0.1),
        "diff_lq2": nrm((L, DH_B), 0.1),
        "diff_lk2": nrm((L, DH_B), 0.1),
        "diff_norm": gain((L, DV_B)),
        "gla_wg_f": nrm((L, GATE_RANK, H_C * DK_C), GATE_RANK ** -0.5),
        "gla_bg_f": nrm((L, H_C * DK_C), 0.1),
        "gla_wg_b": nrm((L, GATE_RANK, H_C * DK_C), GATE_RANK ** -0.5),
        "gla_bg_b": nrm((L, H_C * DK_C), 0.1),
        "gla_norm": gain((L, DV_C)),
        "w_out": nrm((L, MIX_WIDTH, D), MIX_WIDTH ** -0.5),
        "norm_ffn2": gain((L, D)),
        "ffn2_w13": nrm((L, D, 2 * D_FF), D ** -0.5),
        "ffn2_w2": nrm((L, D_FF, D), D_FF ** -0.5),
        "final_norm": gain((D,)),
    }


def reference(x_prompt, x_sample, cache_mla_ckv, cache_mla_krope, cache_diff_k, cache_diff_v,
              state_gla_fwd, state_gla_bwd, c, c_ctx, w_mod, b_mod, norm_ffn1, ffn1_w13, ffn1_w2,
              norm_mix, w_in, mla_q_norm, mla_w_uq, mla_kv_norm, mla_w_uk, mla_w_uv, mla_out_norm,
              diff_lq1, diff_lk1, diff_lq2, diff_lk2, diff_norm, gla_wg_f, gla_bg_f, gla_wg_b, gla_bg_b,
              gla_norm, w_out, norm_ffn2, ffn2_w13, ffn2_w2, final_norm):
    xp, xs = x_prompt, x_sample
    new_ckv, new_krope, new_dk, new_dv, new_sf, new_sb = [], [], [], [], [], []
    for l in range(DEPTH):
        lp = {
            "norm_ffn1": norm_ffn1[l], "ffn1_w13": ffn1_w13[l], "ffn1_w2": ffn1_w2[l],
            "norm_mix": norm_mix[l], "w_in": w_in[l],
            "mla_q_norm": mla_q_norm[l], "mla_w_uq": mla_w_uq[l], "mla_kv_norm": mla_kv_norm[l],
            "mla_w_uk": mla_w_uk[l], "mla_w_uv": mla_w_uv[l], "mla_out_norm": mla_out_norm[l],
            "diff_lq1": diff_lq1[l], "diff_lk1": diff_lk1[l], "diff_lq2": diff_lq2[l],
            "diff_lk2": diff_lk2[l], "diff_norm": diff_norm[l],
            "gla_wg_f": gla_wg_f[l], "gla_bg_f": gla_bg_f[l], "gla_wg_b": gla_wg_b[l],
            "gla_bg_b": gla_bg_b[l], "gla_norm": gla_norm[l], "w_out": w_out[l],
            "norm_ffn2": norm_ffn2[l], "ffn2_w13": ffn2_w13[l], "ffn2_w2": ffn2_w2[l],
        }
        lam_init = 0.8 - 0.6 * math.exp(-0.3 * l)
        mod_ctx = (jax.nn.silu(c_ctx) @ w_mod[l] + b_mod[l])[None, None, :]
        mod_lat = (jax.nn.silu(c) @ w_mod[l] + b_mod[l])[:, None, :]
        xp, ctx_t = trunk_layer(xp, mod_ctx, lp, lambda u: context_mixer(u, lp, lam_init))
        new_ckv.append(ctx_t[0]); new_krope.append(ctx_t[1]); new_dk.append(ctx_t[2])
        new_dv.append(ctx_t[3]); new_sf.append(ctx_t[4]); new_sb.append(ctx_t[5])
        cached = (cache_mla_ckv[:, l], cache_mla_krope[:, l], cache_diff_k[:, l], cache_diff_v[:, l],
                  state_gla_fwd[:, l], state_gla_bwd[:, l])
        xs, _ = trunk_layer(xs, mod_lat, lp, lambda u: latent_mixer(u, lp, lam_init, cached))
    y_prompt = rmsnorm(xp, final_norm)
    y_sample = rmsnorm(xs, final_norm)
    return (y_prompt, y_sample, jnp.stack(new_ckv, axis=1), jnp.stack(new_krope, axis=1),
            jnp.stack(new_dk, axis=1), jnp.stack(new_dv, axis=1), jnp.stack(new_sf, axis=1),
            jnp.stack(new_sb, axis=1))
```

```cpp
#include <hip/hip_runtime.h>
#include <hip/hip_cooperative_groups.h>
#include <cstdio>
#include <cstdint>
namespace cg = cooperative_groups;
namespace pg8 {
#define PG8_LAS __attribute__((address_space(3)))
typedef unsigned short bf16_t;
typedef short bf16x8 __attribute__((ext_vector_type(8)));
typedef float f32x4 __attribute__((ext_vector_type(4)));
typedef unsigned u32x4 __attribute__((ext_vector_type(4)));
constexpr int BM = 256, BK = 64, HALF = 128, HTB = HALF * BK * 2  , STAGE_BYTES = 8 * HTB, NXCD = 8, WGM = 8;

__host__ __device__ __forceinline__ int lds_byte(int r, int c) { const int st = (r >> 4) * 2 + (c >> 5), rr = r & 15, cc = c & 31, ob = rr * 64 + cc * 2; return st * 1024 + (ob ^ (((ob >> 9) & 1) << 5)); }
__host__ __device__ __forceinline__ void stage_rc(int b, int& R, int& C) { const int st = b / 1024, sb = b % 1024, swz = sb ^ (((sb >> 9) & 1) << 5); R = (st >> 1) * 16 + swz / 64; C = (st & 1) * 32 + (swz % 64) / 2; }
__host__ __device__ __forceinline__ int perm32(int rho) { const int n = rho >> 4, i = rho & 15; return 8 * (i >> 2) + 4 * n + (i & 3); }

struct Unit { int pm, pn; };
struct Gemm { const bf16_t* A; const bf16_t* Bt; int M, N, K; };

struct StaticOrder {
    int nM, nN, nwg, G, c;
    __host__ __device__ void init(int M, int N, int G_, int c_) { nM = M / BM; nN = N / BM; nwg = nM * nN; G = G_; c = c_; }
    __host__ __device__ bool next(int i, Unit& u) const {
        const long L = (long)i * G + c; if (L >= nwg) return false;
        int wgid = (int)L; { const int q = nwg / NXCD, r = nwg % NXCD, xcd = wgid % NXCD, off = wgid / NXCD; wgid = (xcd < r ? xcd * (q + 1) : r * (q + 1) + (xcd - r) * q) + off; }
        const int nig = WGM * nN, gid = wgid / nig, fm = gid * WGM, gsz = (nM - fm) < WGM ? (nM - fm) : WGM;
        u.pm = fm + ((wgid % nig) % gsz); u.pn = (wgid % nig) / gsz; return true;
    }
    __device__ __forceinline__ void a_ready(const Unit&) const {}
    __device__ __forceinline__ void done(const Unit&) const {}
};

__device__ __forceinline__ unsigned cvt_pk_bf16(float lo, float hi) { unsigned r; asm volatile("v_cvt_pk_bf16_f32 %0, %1, %2" : "=v"(r) : "v"(lo), "v"(hi)); return r; }
struct EpiSwiglu {
    static constexpr bool PERM = true, AFTER_DRAIN = false;
    bf16_t* O; int ldc;
    __device__ __forceinline__ void operator()(const f32x4 (&acc)[2][2][4][2], const Unit& u, int wr, int wc, int fr, int fq) const {
        const int row0 = u.pm * BM + wr * 64 + fr; const int col0 = u.pn * HALF + wc * 32 + 8 * fq;
#pragma unroll
        for (int ai = 0; ai < 2; ++ai)
#pragma unroll
            for (int m = 0; m < 4; ++m) {
                bf16_t* rowp = O + (size_t)(row0 + ai * HALF + m * 16) * ldc + col0;
                float r[8];
#pragma unroll
                for (int n = 0; n < 2; ++n)
#pragma unroll
                    for (int e = 0; e < 4; ++e) { const float a = acc[ai][0][m][n][e], b = acc[ai][1][m][n][e];
                        const float s = a * __builtin_amdgcn_rcpf(1.0f + __builtin_amdgcn_exp2f(-1.4426950408889634f * a)); r[n * 4 + e] = s * b; }
                u32x4 w; w.x = cvt_pk_bf16(r[0], r[1]); w.y = cvt_pk_bf16(r[2], r[3]); w.z = cvt_pk_bf16(r[4], r[5]); w.w = cvt_pk_bf16(r[6], r[7]);
                *(u32x4*)rowp = w;
            }
    }
};
struct EpiResid {
    static constexpr bool PERM = false, AFTER_DRAIN = false;
    const float* xin_ctx; const float* xin_lat; float* out; const float* gate_base; float gs;
    __device__ __forceinline__ void operator()(const f32x4 (&acc)[2][2][4][2], const Unit& u, int wr, int wc, int fr, int fq) const {
        const int bk = u.pm < 32 ? 0 : 1 + ((u.pm - 32) >> 2);
        const float* gate = gate_base + bk * 9216;
        const float* xin = u.pm < 32 ? xin_ctx : xin_lat; const size_t xoff = u.pm < 32 ? 0 : (size_t)8192 * 1024;
        const int col0 = u.pn * BM + wc * 32 + 4 * fq;
#pragma unroll
        for (int bj = 0; bj < 2; ++bj)
#pragma unroll
            for (int n = 0; n < 2; ++n) {
                const f32x4 gv = *(const f32x4*)(gate + col0 + bj * HALF + n * 16) * gs;
#pragma unroll
                for (int ai = 0; ai < 2; ++ai)
#pragma unroll
                    for (int m = 0; m < 4; ++m) {
                        const size_t off = (size_t)(u.pm * BM + ai * HALF + wr * 64 + m * 16 + fr) * 1024 + col0 + bj * HALF + n * 16;
                        const f32x4 xv = *(const f32x4*)(xin + (off - xoff));
                        *(f32x4*)(out + off) = xv + gv * acc[ai][bj][m][n];
                    }
            }
    }
};
struct EpiBf16P {
    static constexpr bool PERM = true, AFTER_DRAIN = false;
    bf16_t* O; int ldc;
    __device__ __forceinline__ void operator()(const f32x4 (&acc)[2][2][4][2], const Unit& u, int wr, int wc, int fr, int fq) const {
        const int row0 = u.pm * BM + wr * 64 + fr; const int col0 = u.pn * BM + wc * 32 + 8 * fq;
#pragma unroll
        for (int ai = 0; ai < 2; ++ai)
#pragma unroll
            for (int m = 0; m < 4; ++m) {
                bf16_t* rowp = O + (size_t)(row0 + ai * HALF + m * 16) * ldc + col0;
#pragma unroll
                for (int bj = 0; bj < 2; ++bj) { const f32x4 v0 = acc[ai][bj][m][0], v1 = acc[ai][bj][m][1];
                    u32x4 w; w.x = cvt_pk_bf16(v0[0], v0[1]); w.y = cvt_pk_bf16(v0[2], v0[3]); w.z = cvt_pk_bf16(v1[0], v1[1]); w.w = cvt_pk_bf16(v1[2], v1[3]);
                    *(u32x4*)(rowp + bj * HALF) = w; }
            }
    }
};
template <class Epi, class Sched, bool ALIGN_EPI = false, bool SP2 = false>
__device__ __forceinline__ void gemm_phase(PG8_LAS unsigned char* lds, const Gemm g, const Sched& S, const Epi& E) {
    int tid_ = threadIdx.x; asm volatile("" : "+v"(tid_));
    const int tid = tid_, wid = __builtin_amdgcn_readfirstlane(tid >> 6), lane = tid & 63, wr = wid >> 2, wc = wid & 3, fr = lane & 15, fq = lane >> 4;
    const int K = g.K, nt = K / BK;
    unsigned voffA[2], voffB[2];
#pragma unroll
    for (int i = 0; i < 2; ++i) { int R, C; stage_rc(tid * 16 + i * 8192, R, C); const int Rb = Epi::PERM ? ((R & ~31) + perm32(R & 31)) : R;
        voffA[i] = (unsigned)(R * K + C) * 2u; voffB[i] = (unsigned)(Rb * K + C) * 2u; }
    const size_t kstep = (size_t)(BK * 2);
    const size_t hstep = (size_t)HALF * K * 2;
    const size_t tstep = 2 * hstep;
    const unsigned ldsw = (unsigned)wid * 1024u;
    const int aoff = lds_byte(wr * 64 + fr, fq * 8), boff = lds_byte(wc * 32 + fr, fq * 8);
#define PG8_SA(b, h) (((b) * 2 + (h)) * HTB)
#define PG8_SB(b, h) ((4 + (b) * 2 + (h)) * HTB)
#define PG8_STAGE(bufoff, gbase, voff) do { _Pragma("unroll") for (int _i = 0; _i < 2; ++_i) \
        __builtin_amdgcn_global_load_lds((const unsigned*)((const char*)(gbase) + (voff)[_i]), (PG8_LAS unsigned*)(lds + (bufoff) + ldsw + _i * 8192), 16, 0, 0); } while (0)
#define PG8_LDA(dst, b, h) do { _Pragma("unroll") for (int m = 0; m < 4; ++m) _Pragma("unroll") for (int k = 0; k < 2; ++k) dst[m][k] = *(const PG8_LAS bf16x8*)(lds + PG8_SA(b, h) + aoff + m * 2048 + k * 1024); } while (0)
#define PG8_LDB(dst, b, h) do { _Pragma("unroll") for (int n = 0; n < 2; ++n) _Pragma("unroll") for (int k = 0; k < 2; ++k) dst[n][k] = *(const PG8_LAS bf16x8*)(lds + PG8_SB(b, h) + boff + n * 2048 + k * 1024); } while (0)
#define PG8_MMA(ai, bj, At, Bt) do { __builtin_amdgcn_s_setprio(1); _Pragma("unroll") for (int m = 0; m < 4; ++m) _Pragma("unroll") for (int n = 0; n < 2; ++n) _Pragma("unroll") for (int k = 0; k < 2; ++k) \
        acc[ai][bj][m][n] = __builtin_amdgcn_mfma_f32_16x16x32_bf16(Bt[n][k], At[m][k], acc[ai][bj][m][n], 0, 0, 0); __builtin_amdgcn_s_setprio(0); } while (0)
#define PG8_WAIT_V(n) asm volatile("s_waitcnt vmcnt(" #n ")" ::: "memory")
#define PG8_WAIT_L(n) asm volatile("s_waitcnt lgkmcnt(" #n ")" ::: "memory")
#define PG8_BAR __builtin_amdgcn_s_barrier()
#define PG8_SCHED __builtin_amdgcn_sched_barrier(0)
    Unit cur, nxt; int ui = 0;
    if (!S.next(0, cur)) return;
    f32x4 acc[2][2][4][2];
#pragma unroll
    for (int a = 0; a < 2; ++a)
#pragma unroll
        for (int b = 0; b < 2; ++b)
#pragma unroll
            for (int m = 0; m < 4; ++m)
#pragma unroll
                for (int n = 0; n < 2; ++n) acc[a][b][m][n] = (f32x4){0.f, 0.f, 0.f, 0.f};
    bf16x8 At[4][2], B0[2][2], B1[2][2];
    const char* cA = (const char*)g.A + (size_t)cur.pm * tstep; const char* cB = (const char*)g.Bt + (size_t)cur.pn * tstep;
    S.a_ready(cur);
    if constexpr (SP2) {
        PG8_STAGE(PG8_SB(0, 0), cB, voffB); PG8_STAGE(PG8_SB(0, 1), cB + hstep, voffB); PG8_STAGE(PG8_SA(0, 0), cA, voffA); PG8_STAGE(PG8_SA(0, 1), cA + hstep, voffA);
        if (wr == 1) PG8_BAR;
        PG8_WAIT_V(2); PG8_BAR;
        PG8_STAGE(PG8_SB(1, 0), cB + kstep, voffB); PG8_STAGE(PG8_SA(1, 0), cA + kstep, voffA); PG8_STAGE(PG8_SB(1, 1), cB + hstep + kstep, voffB);
        PG8_WAIT_V(6); PG8_BAR;
    } else {
        PG8_STAGE(PG8_SB(0, 0), cB, voffB); PG8_STAGE(PG8_SA(0, 0), cA, voffA); PG8_STAGE(PG8_SB(0, 1), cB + hstep, voffB); PG8_STAGE(PG8_SA(0, 1), cA + hstep, voffA);
        if (wr == 1) PG8_BAR;
        PG8_WAIT_V(4); PG8_BAR;
        PG8_STAGE(PG8_SB(1, 0), cB + kstep, voffB); PG8_STAGE(PG8_SA(1, 0), cA + kstep, voffA); PG8_STAGE(PG8_SB(1, 1), cB + hstep + kstep, voffB);
        PG8_WAIT_V(6); PG8_BAR;
    }
    for (;;) {
        const bool has_next = S.next(ui + 1, nxt);
        const char* nA = has_next ? (const char*)g.A + (size_t)nxt.pm * tstep : cA; const char* nB = has_next ? (const char*)g.Bt + (size_t)nxt.pn * tstep : cB;
        for (int t = 0; t < nt; t += 2) {
            const bool last = (t == nt - 2);
            const char* a1 = cA + (size_t)(t + 1) * kstep;
            const char* a2 = last ? nA : cA + (size_t)(t + 2) * kstep; const char* b2 = last ? nB : cB + (size_t)(t + 2) * kstep;
            const char* a3 = a2 + kstep; const char* b3 = b2 + kstep;
            if (last && has_next) S.a_ready(nxt);
            if constexpr (SP2) {
            PG8_LDB(B0, 0, 0); PG8_LDB(B1, 0, 1); PG8_SCHED; PG8_LDA(At, 0, 0); PG8_STAGE(PG8_SA(1, 1), a1 + hstep, voffA);
            PG8_WAIT_V(8); PG8_WAIT_L(0); PG8_BAR; PG8_MMA(0, 0, At, B0); PG8_MMA(0, 1, At, B1); PG8_BAR; PG8_SCHED;
            PG8_LDA(At, 0, 1); PG8_STAGE(PG8_SB(0, 0), b2, voffB); PG8_STAGE(PG8_SB(0, 1), b2 + hstep, voffB); PG8_STAGE(PG8_SA(0, 0), a2, voffA);
            PG8_WAIT_V(8); PG8_WAIT_L(0); PG8_BAR; PG8_MMA(1, 0, At, B0); PG8_MMA(1, 1, At, B1); PG8_BAR; PG8_SCHED;
            PG8_LDB(B0, 1, 0); PG8_LDB(B1, 1, 1); PG8_SCHED; PG8_LDA(At, 1, 0); PG8_STAGE(PG8_SA(0, 1), a2 + hstep, voffA);
            PG8_WAIT_V(8); PG8_WAIT_L(0); PG8_BAR; PG8_MMA(0, 0, At, B0); PG8_MMA(0, 1, At, B1); PG8_BAR; PG8_SCHED;
            PG8_LDA(At, 1, 1); PG8_STAGE(PG8_SB(1, 0), b3, voffB); PG8_STAGE(PG8_SB(1, 1), b3 + hstep, voffB); PG8_STAGE(PG8_SA(1, 0), a3, voffA);
            PG8_WAIT_V(8); PG8_WAIT_L(0); PG8_BAR; PG8_MMA(1, 0, At, B0); PG8_MMA(1, 1, At, B1); PG8_BAR; PG8_SCHED;
            } else {
            PG8_LDB(B0, 0, 0); PG8_SCHED; PG8_LDA(At, 0, 0); PG8_STAGE(PG8_SA(1, 1), a1 + hstep, voffA);
            PG8_WAIT_L(8); PG8_BAR; PG8_WAIT_L(0); PG8_MMA(0, 0, At, B0); PG8_BAR; PG8_SCHED;
            PG8_LDB(B1, 0, 1); PG8_STAGE(PG8_SB(0, 0), b2, voffB);
            PG8_BAR; PG8_WAIT_L(0); PG8_MMA(0, 1, At, B1); PG8_BAR;
            PG8_LDA(At, 0, 1); PG8_STAGE(PG8_SA(0, 0), a2, voffA);
            PG8_BAR; PG8_WAIT_L(0); PG8_MMA(1, 0, At, B0); PG8_BAR; PG8_SCHED;
            PG8_STAGE(PG8_SB(0, 1), b2 + hstep, voffB);
            PG8_WAIT_V(6); PG8_BAR; PG8_MMA(1, 1, At, B1); PG8_BAR;
            PG8_LDB(B0, 1, 0); PG8_SCHED; PG8_LDA(At, 1, 0); PG8_STAGE(PG8_SA(0, 1), a2 + hstep, voffA);
            PG8_WAIT_L(8); PG8_BAR; PG8_WAIT_L(0); PG8_MMA(0, 0, At, B0); PG8_BAR; PG8_SCHED;
            PG8_LDB(B1, 1, 1); PG8_STAGE(PG8_SB(1, 0), b3, voffB);
            PG8_BAR; PG8_WAIT_L(0); PG8_MMA(0, 1, At, B1); PG8_BAR;
            PG8_LDA(At, 1, 1); PG8_STAGE(PG8_SA(1, 0), a3, voffA);
            PG8_BAR; PG8_WAIT_L(0); PG8_MMA(1, 0, At, B0); PG8_BAR; PG8_SCHED;
            PG8_STAGE(PG8_SB(1, 1), b3 + hstep, voffB);
            PG8_WAIT_V(6); PG8_BAR; PG8_MMA(1, 1, At, B1); PG8_BAR;
            }
        }
        if constexpr (ALIGN_EPI) { if (wr == 0) PG8_BAR; }
        if constexpr (!Epi::AFTER_DRAIN) { E(acc, cur, wr, wc, fr, fq); S.done(cur); }
        if (!has_next) break;
#pragma unroll
        for (int a = 0; a < 2; ++a)
#pragma unroll
            for (int b = 0; b < 2; ++b)
#pragma unroll
                for (int m = 0; m < 4; ++m)
#pragma unroll
                    for (int n = 0; n < 2; ++n) acc[a][b][m][n] = (f32x4){0.f, 0.f, 0.f, 0.f};
        cur = nxt; cA = nA; cB = nB; ++ui;
        if constexpr (ALIGN_EPI) { if (wr == 1) PG8_BAR; }
    }
    PG8_WAIT_V(0);
    if constexpr (!ALIGN_EPI) { if (wr == 0) PG8_BAR; }
    PG8_BAR;
    if constexpr (Epi::AFTER_DRAIN) { E.fused(acc, cur, wr, wc, fr, fq, lds, wid, lane); S.done(cur); }
#undef PG8_SA
#undef PG8_SB
#undef PG8_STAGE
#undef PG8_LDA
#undef PG8_LDB
#undef PG8_MMA
#undef PG8_WAIT_V
#undef PG8_WAIT_L
#undef PG8_BAR
#undef PG8_SCHED
}
}
#define LAS __attribute__((address_space(3)))
typedef unsigned short bf16;
typedef unsigned v4u __attribute__((ext_vector_type(4)));
typedef unsigned v2u __attribute__((ext_vector_type(2)));
typedef float f32x4 __attribute__((ext_vector_type(4)));
typedef short bf16x8 __attribute__((ext_vector_type(8)));
typedef short s16x4 __attribute__((ext_vector_type(4)));

constexpr int NWAVES = 8, NTHR = 512;
constexpr int LDS_BYTES = 147456;
constexpr int D = 1024, MTOK = 16384, MCTX = 8192, NKEYROWS = 18432, DFF = 2816, PCOLS = 2816;
constexpr float EPS = 1e-6f;
constexpr size_t MiB = 1u << 20;
constexpr size_t WS_CTL = 0, WS_MOD = 1 * MiB, WS_ROPE = 1 * MiB + 768 * 1024;
constexpr size_t WS_WT13A = 2 * MiB, WS_WT13B = 13 * MiB, WS_WT2A = 24 * MiB, WS_WT2B = 24 * MiB + 5632 * 1024, WS_WTIN = 35 * MiB;
constexpr size_t WS_WTUQ = 40 * MiB + 512 * 1024, WS_WTUKV = 41 * MiB + 256 * 1024, WS_WTOUT = 42 * MiB;
constexpr size_t WS_PH = 44 * MiB, WS_U = 132 * MiB, WS_CQN = 164 * MiB, WS_CKV = 176 * MiB, WS_KR = 185 * MiB, WS_KB = 187 * MiB, WS_VB = 196 * MiB;
constexpr size_t WS_QB = 205 * MiB, WS_QA = 213 * MiB, WS_KNV = 237 * MiB, WS_OCB = 264 * MiB, WS_END = 276 * MiB;
constexpr size_t O_X = 0, O_CKV = 16777216, O_KR = 20971520, O_DK = 21495808, O_DV = 25690112, O_SF = 29884416, O_SB = 31064064;
constexpr int PC_CQ = 0, PC_CKV = 384, PC_KR = 640, PC_QB = 672, PC_KB = 928, PC_VB = 1184, PC_GQ = 1440, PC_GK = 1632, PC_GV = 1824, PC_RC = 2208, PC_GLF = 2592;

enum { I_XP = 0, I_XS, I_CCKV, I_CKR, I_CDK, I_CDV, I_SF, I_SB, I_C, I_CCTX, I_WMOD, I_BMOD, I_NF1, I_F1W13, I_F1W2, I_NMIX, I_WIN, I_QNORM, I_WUQ, I_KVNORM,
       I_WUK, I_WUV, I_ONORM, I_LQ1, I_LK1, I_LQ2, I_LK2, I_DNORM, I_WGF, I_BGF, I_WGB, I_BGB, I_GNORM, I_WOUT, I_NF2, I_F2W13, I_F2W2, I_FNORM, N_IN };

struct Args { const float* in[N_IN]; float* out; unsigned char* ws; };

__device__ __forceinline__ float bf2f(unsigned short h) { return __uint_as_float((unsigned)h << 16); }
__device__ __forceinline__ float bflo(unsigned w) { return __uint_as_float(w << 16); }
__device__ __forceinline__ float bfhi(unsigned w) { return __uint_as_float(w & 0xffff0000u); }
__device__ __forceinline__ unsigned pk2(float lo, float hi) { return pg8::cvt_pk_bf16(lo, hi); }
__device__ __forceinline__ unsigned short f2bf(float f) { return (unsigned short)(pk2(f, 0.f) & 0xffffu); }
__device__ __forceinline__ float wave_sum(float v) {
#pragma unroll
    for (int o = 1; o < 64; o <<= 1) v += __shfl_xor(v, o);
    return v;
}
__device__ __forceinline__ float grp16_sum(float v) {
#pragma unroll
    for (int o = 1; o < 16; o <<= 1) v += __shfl_xor(v, o);
    return v;
}
__device__ __forceinline__ f32x4 mfma16(bf16x8 a, bf16x8 b, f32x4 c) { return __builtin_amdgcn_mfma_f32_16x16x32_bf16(a, b, c, 0, 0, 0); }
typedef short v4i16_t __attribute__((ext_vector_type(4)));
__device__ __forceinline__ s16x4 vtr(LAS const unsigned char* p) { return __builtin_bit_cast(s16x4, __builtin_amdgcn_ds_read_tr16_b64_v4i16((LAS v4i16_t*)p)); }

typedef const float* cfp_t;
typedef __attribute__((address_space(4))) const cfp_t* inptr_t;
struct Frame {
    LAS unsigned char* lds;
    int tid, lane, wave, G, gw, ngw;
    inptr_t in; float* out; unsigned char* ws;
};

__device__ __forceinline__ void transpose_item(const float* W, int K, int N, bf16* WT, int row_off, LAS float* scr, int kb, int nb, int lane) {
    const int k0 = 64 * kb, n0 = 32 * nb;
#pragma unroll 8
    for (int i = 0; i < 32; ++i) { const int kk = 2 * i + (lane >> 5); scr[kk * 33 + (lane & 31)] = W[(size_t)(k0 + kk) * N + n0 + (lane & 31)]; }
    asm volatile("s_waitcnt lgkmcnt(0)" ::: "memory");
    const int c = lane & 7;
#pragma unroll
    for (int j = 0; j < 4; ++j) { const int n = (lane >> 3) + 8 * j; const LAS float* s = scr + (8 * c) * 33 + n;
        v4u o; o.x = pk2(s[0 * 33], s[1 * 33]); o.y = pk2(s[2 * 33], s[3 * 33]); o.z = pk2(s[4 * 33], s[5 * 33]); o.w = pk2(s[6 * 33], s[7 * 33]);
        *(v4u*)(WT + (size_t)(row_off + n0 + n) * K + k0 + 8 * c) = o; }
    asm volatile("s_waitcnt lgkmcnt(0)" ::: "memory");
}

__device__ __forceinline__ void prep_phase(Frame& F, int l) {
    LAS float* scr = (LAS float*)(F.lds + F.wave * 8704);
    unsigned char* ws = F.ws;
    constexpr int I13 = 16 * 176, I2 = 44 * 32, IIN = 16 * 82, IUQ = 6 * 18, IUK = 4 * 12, IOUT = 16 * 32;
    constexpr int NIT = 2 * I13 + 2 * I2 + IIN + IUQ + 2 * IUK + IOUT;
    for (int it = F.gw; it < NIT; it += F.ngw) {
        int r = it;
        if (r < 2 * I13) { const int f = r >= I13; r -= f * I13; const int kb = r / 176, nb = r % 176; const int n0 = 32 * nb; const int half = n0 >= DFF; const int j = n0 - half * DFF;
            const int orow = 256 * (j >> 7) + 128 * half + (j & 127);
            transpose_item(F.in[f ? I_F2W13 : I_F1W13] + (size_t)l * 1024 * 5632, 1024, 5632, (bf16*)(ws + (f ? WS_WT13B : WS_WT13A)), orow - n0, scr, kb, nb, F.lane); continue; }
        r -= 2 * I13;
        if (r < 2 * I2) { const int f = r >= I2; r -= f * I2; transpose_item(F.in[f ? I_F2W2 : I_F1W2] + (size_t)l * DFF * 1024, DFF, 1024, (bf16*)(ws + (f ? WS_WT2B : WS_WT2A)), 0, scr, r / 32, r % 32, F.lane); continue; }
        r -= 2 * I2;
        if (r < IIN) { transpose_item(F.in[I_WIN] + (size_t)l * 1024 * 2624, 1024, 2624, (bf16*)(ws + WS_WTIN), 0, scr, r / 82, r % 82, F.lane); continue; }
        r -= IIN;
        if (r < IUQ) { transpose_item(F.in[I_WUQ] + (size_t)l * 384 * 576, 384, 576, (bf16*)(ws + WS_WTUQ), 0, scr, r / 18, r % 18, F.lane); continue; }
        r -= IUQ;
        if (r < 2 * IUK) { const int f = r >= IUK; r -= f * IUK; transpose_item(F.in[f ? I_WUV : I_WUK] + (size_t)l * 256 * 384, 256, 384, (bf16*)(ws + WS_WTUKV), f * 384, scr, r / 12, r % 12, F.lane); continue; }
        r -= 2 * IUK;
        transpose_item(F.in[I_WOUT] + (size_t)l * 1024 * 1024, 1024, 1024, (bf16*)(ws + WS_WTOUT), 0, scr, r / 32, r % 32, F.lane);
    }
    { const int gt = blockIdx.x * NTHR + F.tid, ngt = F.G * NTHR;
      v4u z = {0u, 0u, 0u, 0u};
      v4u* p1 = (v4u*)(ws + WS_WTIN + (size_t)2624 * 1024 * 2); for (int i = gt; i < 192 * 1024 * 2 / 16; i += ngt) p1[i] = z;
      v4u* p2 = (v4u*)(ws + WS_WTUQ + (size_t)576 * 384 * 2); for (int i = gt; i < 192 * 384 * 2 / 16; i += ngt) p2[i] = z; }
    if (l != 0) return;
    if (blockIdx.x == F.G - 1) { const int pos = F.tid >> 3, i = F.tid & 7; const float inv = exp2f(-(float)i * 1.6609640474436813f);
        const float rev = (float)pos * inv * 0.15915494309189535f; float* R = (float*)(ws + WS_ROPE);
        R[F.tid * 2] = __builtin_amdgcn_cosf(rev); R[F.tid * 2 + 1] = __builtin_amdgcn_sinf(rev); }
    LAS float* sc = (LAS float*)(F.lds + 69632);
    LAS float* part = (LAS float*)(F.lds + 106496);
    __syncthreads();
    for (int i = F.tid; i < 9 * 1024; i += NTHR) { const int b = i >> 10, k = i & 1023; const float c = b == 0 ? F.in[I_CCTX][k] : F.in[I_C][(b - 1) * 1024 + k]; sc[i] = c / (1.0f + __expf(-c)); }
    __syncthreads();
    float* MOD = (float*)(ws + WS_MOD);
    for (int j = blockIdx.x; j < 288; j += F.G) {
        const int ll = j / 144, c0 = (j % 144) * 64;
        const float* wp = F.in[I_WMOD] + (size_t)ll * 1024 * 9216 + (size_t)(F.wave * 128) * 9216 + c0 + F.lane;
        float a0 = 0.f, a1 = 0.f, a2 = 0.f, a3 = 0.f, a4 = 0.f, a5 = 0.f, a6 = 0.f, a7 = 0.f, a8 = 0.f;
#pragma unroll 8
        for (int kk = 0; kk < 128; ++kk) { const float w = wp[(size_t)kk * 9216]; const LAS float* s = sc + F.wave * 128 + kk;
            a0 += s[0] * w; a1 += s[1024] * w; a2 += s[2048] * w; a3 += s[3072] * w; a4 += s[4096] * w; a5 += s[5120] * w; a6 += s[6144] * w; a7 += s[7168] * w; a8 += s[8192] * w; }
        LAS float* pp = part + F.wave * 576 + F.lane;
        pp[0] = a0; pp[64] = a1; pp[128] = a2; pp[192] = a3; pp[256] = a4; pp[320] = a5; pp[384] = a6; pp[448] = a7; pp[512] = a8;
        __syncthreads();
        for (int i = F.tid; i < 576; i += NTHR) { float s = 0.f;
#pragma unroll
            for (int w = 0; w < 8; ++w) s += part[w * 576 + i];
            const int b = i >> 6, c = i & 63; MOD[(size_t)(ll * 9 + b) * 9216 + c0 + c] = s + F.in[I_BMOD][ll * 9216 + c0 + c]; }
        __syncthreads();
    }
}

__device__ __forceinline__ void norm_phase(Frame& F, const float* xc, const float* xl, const float* gain, const float* modl, int ni, bf16* U) {
    for (int m = F.gw; m < MTOK; m += F.ngw) {
        const float* xr = m < MCTX ? xc + (size_t)m * D : xl + (size_t)(m - MCTX) * D;
        const int bk = m < MCTX ? 0 : 1 + ((m - MCTX) >> 10);
        const float* sh = modl + bk * 9216 + (3 * ni) * 1024; const float* sc = sh + 1024;
        f32x4 v[4]; float ss = 0.f;
#pragma unroll
        for (int j = 0; j < 4; ++j) { v[j] = *(const f32x4*)(xr + 4 * F.lane + 256 * j); ss += (v[j].x * v[j].x + v[j].y * v[j].y) + (v[j].z * v[j].z + v[j].w * v[j].w); }
        const float rstd = rsqrtf(wave_sum(ss) * (1.0f / D) + EPS);
#pragma unroll
        for (int j = 0; j < 4; ++j) { const int k = 4 * F.lane + 256 * j;
            const f32x4 g = *(const f32x4*)(gain + k), s1 = *(const f32x4*)(sc + k), s0 = *(const f32x4*)(sh + k);
            const f32x4 y = v[j] * rstd * g * (s1 + 1.0f) + s0;
            v2u o; o.x = pk2(y.x, y.y); o.y = pk2(y.z, y.w); *(v2u*)(U + (size_t)m * D + k) = o; }
    }
}
__device__ __forceinline__ void final_norm_phase(Frame& F, float* X, const float* gain) {
    for (int m = F.gw; m < MTOK; m += F.ngw) {
        float* xr = X + (size_t)m * D;
        f32x4 v[4]; float ss = 0.f;
#pragma unroll
        for (int j = 0; j < 4; ++j) { v[j] = *(const f32x4*)(xr + 4 * F.lane + 256 * j); ss += (v[j].x * v[j].x + v[j].y * v[j].y) + (v[j].z * v[j].z + v[j].w * v[j].w); }
        const float rstd = rsqrtf(wave_sum(ss) * (1.0f / D) + EPS);
#pragma unroll
        for (int j = 0; j < 4; ++j) { const int k = 4 * F.lane + 256 * j; const f32x4 g = *(const f32x4*)(gain + k); *(f32x4*)(xr + k) = v[j] * rstd * g; }
    }
}

__device__ __forceinline__ void rope4(float (&x)[4], int lane, int t, const float* R) {
    const int part = (lane & 7) >> 2, second = (lane & 3) >> 1, i0 = (lane & 1) * 4; const int pos = part ? (t & 63) : (t >> 6);
#pragma unroll
    for (int e = 0; e < 4; ++e) { const float xp = __shfl_xor(x[e], 2); const float c = R[(pos * 8 + i0 + e) * 2], s = R[(pos * 8 + i0 + e) * 2 + 1];
        x[e] = second ? (xp * s + x[e] * c) : (x[e] * c - xp * s); }
}
__device__ __forceinline__ void postproj_phase(Frame& F, int l) {
    unsigned char* ws = F.ws; const bf16* P = (const bf16*)(ws + WS_PH); const float* R = (const float*)(ws + WS_ROPE);
    bf16* CQN = (bf16*)(ws + WS_CQN); bf16* CKV = (bf16*)(ws + WS_CKV); bf16* KR = (bf16*)(ws + WS_KR); bf16* KB = (bf16*)(ws + WS_KB); bf16* VB = (bf16*)(ws + WS_VB); bf16* QB = (bf16*)(ws + WS_QB);
    const float* qn = F.in[I_QNORM] + l * 384; const float* kvn = F.in[I_KVNORM] + l * 256;
    const int lane = F.lane;
    for (int m = F.gw; m < MTOK + 2048; m += F.ngw) {
        if (m < MTOK) {
            const bf16* pr = P + (size_t)m * PCOLS;
            const bool isctx = m < MCTX; const int b = isctx ? (m >> 8) : ((m - MCTX) >> 10), t = isctx ? (m & 255) : ((m - MCTX) & 1023);
            const int keyrow = isctx ? m : MCTX + b * 1280 + 256 + t; const size_t orow = (size_t)((b * 2 + l) * 256 + t);
            {
                unsigned w[3]; float ss = 0.f;
#pragma unroll
                for (int j = 0; j < 3; ++j) { w[j] = *(const unsigned*)(pr + PC_CQ + 2 * lane + 128 * j); const float a = bflo(w[j]), c = bfhi(w[j]); ss += a * a + c * c; }
                const float rstd = rsqrtf(wave_sum(ss) * (1.0f / 384.0f) + EPS);
#pragma unroll
                for (int j = 0; j < 3; ++j) { const int idx = 2 * lane + 128 * j; *(unsigned*)(CQN + (size_t)m * 384 + idx) = pk2(bflo(w[j]) * rstd * qn[idx], bfhi(w[j]) * rstd * qn[idx + 1]); }
            }
            {
                const v2u w = *(const v2u*)(pr + PC_CKV + 4 * lane); float x[4] = {bflo(w.x), bfhi(w.x), bflo(w.y), bfhi(w.y)};
                const float ss = (x[0] * x[0] + x[1] * x[1]) + (x[2] * x[2] + x[3] * x[3]);
                const float rstd = rsqrtf(wave_sum(ss) * (1.0f / 256.0f) + EPS);
                const f32x4 g = *(const f32x4*)(kvn + 4 * lane); f32x4 y = {x[0] * rstd * g.x, x[1] * rstd * g.y, x[2] * rstd * g.z, x[3] * rstd * g.w};
                if (isctx) *(f32x4*)(F.out + O_CKV + orow * 256 + 4 * lane) = y;
                v2u o; o.x = pk2(y.x, y.y); o.y = pk2(y.z, y.w); *(v2u*)(CKV + (size_t)keyrow * 256 + 4 * lane) = o;
            }
            {
                const int j = lane & 31; float x = bf2f(pr[PC_KR + j]); const float xp = __shfl_xor(x, 8);
                if (!isctx) { const int part = j >> 4, i = j & 7, second = (j >> 3) & 1; const int pos = part ? (t & 63) : (t >> 6);
                    const float c = R[(pos * 8 + i) * 2], s = R[(pos * 8 + i) * 2 + 1]; x = second ? (xp * s + x * c) : (x * c - xp * s); }
                if (lane < 32) { if (isctx) F.out[O_KR + orow * 32 + lane] = x; KR[(size_t)keyrow * 32 + lane] = f2bf(x); }
            }
            {
                const v2u w = *(const v2u*)(pr + PC_QB + 4 * lane); float x[4] = {bflo(w.x), bfhi(w.x), bflo(w.y), bfhi(w.y)};
                if (!isctx) rope4(x, lane, t, R);
                v2u o; o.x = pk2(x[0], x[1]); o.y = pk2(x[2], x[3]); *(v2u*)(QB + (size_t)m * 256 + 4 * lane) = o;
            }
            {
                const v2u w = *(const v2u*)(pr + PC_KB + 4 * lane); float x[4] = {bflo(w.x), bfhi(w.x), bflo(w.y), bfhi(w.y)};
                if (isctx) *(f32x4*)(F.out + O_DK + orow * 256 + 4 * lane) = (f32x4){x[0], x[1], x[2], x[3]};
                else rope4(x, lane, t, R);
                v2u o; o.x = pk2(x[0], x[1]); o.y = pk2(x[2], x[3]); *(v2u*)(KB + (size_t)keyrow * 256 + 4 * lane) = o;
            }
            {
                const v2u w = *(const v2u*)(pr + PC_VB + 4 * lane);
                if (isctx) *(f32x4*)(F.out + O_DV + orow * 256 + 4 * lane) = (f32x4){bflo(w.x), bfhi(w.x), bflo(w.y), bfhi(w.y)};
                *(v2u*)(VB + (size_t)keyrow * 256 + 4 * lane) = w;
            }
        } else {
            const int r = m - MTOK, b = r >> 8, j = r & 255; const int keyrow = MCTX + b * 1280 + j; const size_t src = (size_t)((b * 2 + l) * 256 + j);
            { const f32x4 x = *(const f32x4*)(F.in[I_CCKV] + src * 256 + 4 * lane); v2u o; o.x = pk2(x.x, x.y); o.y = pk2(x.z, x.w); *(v2u*)(CKV + (size_t)keyrow * 256 + 4 * lane) = o; }
            if (lane < 32) KR[(size_t)keyrow * 32 + lane] = f2bf(F.in[I_CKR][src * 32 + lane]);
            { const f32x4 x = *(const f32x4*)(F.in[I_CDK] + src * 256 + 4 * lane); v2u o; o.x = pk2(x.x, x.y); o.y = pk2(x.z, x.w); *(v2u*)(KB + (size_t)keyrow * 256 + 4 * lane) = o; }
            { const f32x4 x = *(const f32x4*)(F.in[I_CDV] + src * 256 + 4 * lane); v2u o; o.x = pk2(x.x, x.y); o.y = pk2(x.z, x.w); *(v2u*)(VB + (size_t)keyrow * 256 + 4 * lane) = o; }
        }
    }
}

template <int KS>
__device__ __forceinline__ void attn_tile(const bf16x8 (&qf)[KS], LAS const unsigned char* Kt, int kstr, LAS const unsigned char* Vt, int vstr, float sl2, float& m_, float& l_, f32x4 (&O)[4], int lane) {
    const int r = lane & 15, g = lane >> 4;
    f32x4 s[4];
#pragma unroll
    for (int kt = 0; kt < 4; ++kt) {
        s[kt] = (f32x4){0.f, 0.f, 0.f, 0.f};
        LAS const unsigned char* kp = Kt + (kt * 16 + r) * kstr + g * 16;
#pragma unroll
        for (int ks = 0; ks < KS; ++ks) { const bf16x8 a = *(LAS const bf16x8*)(kp + ks * 64); s[kt] = mfma16(a, qf[ks], s[kt]); }
    }
    float mx = s[0][0];
#pragma unroll
    for (int kt = 0; kt < 4; ++kt)
#pragma unroll
        for (int j = 0; j < 4; ++j) mx = fmaxf(mx, s[kt][j]);
    mx = fmaxf(mx, __shfl_xor(mx, 16)); mx = fmaxf(mx, __shfl_xor(mx, 32));
    const float mn = fmaxf(m_, mx * sl2);
    const float alpha = __builtin_amdgcn_exp2f(m_ - mn);
    float ps = 0.f;
#pragma unroll
    for (int kt = 0; kt < 4; ++kt)
#pragma unroll
        for (int j = 0; j < 4; ++j) { const float p = __builtin_amdgcn_exp2f(s[kt][j] * sl2 - mn); s[kt][j] = p; ps += p; }
    ps += __shfl_xor(ps, 16); ps += __shfl_xor(ps, 32);
    l_ = l_ * alpha + ps; m_ = mn;
#pragma unroll
    for (int dt = 0; dt < 4; ++dt) O[dt] = O[dt] * alpha;
#pragma unroll
    for (int kb = 0; kb < 2; ++kb) {
        v4u pw; pw.x = pk2(s[2 * kb][0], s[2 * kb][1]); pw.y = pk2(s[2 * kb][2], s[2 * kb][3]); pw.z = pk2(s[2 * kb + 1][0], s[2 * kb + 1][1]); pw.w = pk2(s[2 * kb + 1][2], s[2 * kb + 1][3]);
        const bf16x8 pf = __builtin_bit_cast(bf16x8, pw);
#pragma unroll
        for (int dt = 0; dt < 4; ++dt) {
            LAS const unsigned char* vp = Vt + (32 * kb + 4 * g + (r >> 2)) * vstr + (16 * dt + 4 * (r & 3)) * 2;
            const s16x4 lo = vtr(vp), hi = vtr(vp + 16 * vstr);
            const bf16x8 vf = {lo[0], lo[1], lo[2], lo[3], hi[0], hi[1], hi[2], hi[3]};
            O[dt] = mfma16(vf, pf, O[dt]);
        }
    }
}

constexpr int KSTR_A = 208, VSTR = 144, KSTR_B = 144;
constexpr int ATT_K_OFF = 0, ATT_V_OFF = 16384;

__device__ __forceinline__ void mla_unit(Frame& F, int l, bool lat, int b, int h, int qt) {
    unsigned char* ws = F.ws; const bf16* QA = (const bf16*)(ws + WS_QA); const bf16* KNV = (const bf16*)(ws + WS_KNV); const bf16* KR = (const bf16*)(ws + WS_KR); bf16* MIX = (bf16*)(ws + WS_U);
    const int tok0 = lat ? MCTX + b * 1024 + qt * 128 : b * 256 + qt * 128, keyrow0 = lat ? MCTX + b * 1280 : b * 256, NK = lat ? 1280 : 256;
    const int lane = F.lane, r = lane & 15, g = lane >> 4; const int trow = tok0 + 16 * F.wave + r;
    bf16x8 qf[3];
#pragma unroll
    for (int ks = 0; ks < 3; ++ks) qf[ks] = *(const bf16x8*)(QA + (size_t)trow * 768 + h * 96 + 32 * ks + 8 * g);
    if (lat) {
        const float* R = (const float*)(ws + WS_ROPE); const int t = qt * 128 + 16 * F.wave + r; const int pos = g < 2 ? (t >> 6) : (t & 63);
        const v4u me = __builtin_bit_cast(v4u, qf[2]); v4u pa; float o[8];
#pragma unroll
        for (int d = 0; d < 4; ++d) pa[d] = (unsigned)__shfl_xor((int)me[d], 16);
#pragma unroll
        for (int i = 0; i < 8; ++i) { const float x = (i & 1) ? bfhi(me[i >> 1]) : bflo(me[i >> 1]), xp = (i & 1) ? bfhi(pa[i >> 1]) : bflo(pa[i >> 1]);
            const float c = R[(pos * 8 + i) * 2], s = R[(pos * 8 + i) * 2 + 1]; o[i] = (g & 1) ? (xp * s + x * c) : (x * c - xp * s); }
        v4u w; w.x = pk2(o[0], o[1]); w.y = pk2(o[2], o[3]); w.z = pk2(o[4], o[5]); w.w = pk2(o[6], o[7]); qf[2] = __builtin_bit_cast(bf16x8, w);
    }
    float m_ = -1e30f, l_ = 0.f; f32x4 O[4];
#pragma unroll
    for (int dt = 0; dt < 4; ++dt) O[dt] = (f32x4){0.f, 0.f, 0.f, 0.f};
    LAS unsigned char* Kt = F.lds + ATT_K_OFF; LAS unsigned char* Vt = F.lds + ATT_V_OFF;
    const float sl2 = 0.10206207261596575f * 1.4426950408889634f;
    for (int k0 = 0; k0 < NK; k0 += 64) {
        __syncthreads();
        for (int c = F.tid; c < 1280; c += NTHR) {
            if (c < 512) { const int row = c >> 3, ch = c & 7; *(LAS v4u*)(Kt + row * KSTR_A + ch * 16) = *(const v4u*)(KNV + (size_t)(keyrow0 + k0 + row) * 768 + h * 64 + ch * 8); }
            else if (c < 768) { const int cc = c - 512, row = cc >> 2, ch = cc & 3; *(LAS v4u*)(Kt + row * KSTR_A + 128 + ch * 16) = *(const v4u*)(KR + (size_t)(keyrow0 + k0 + row) * 32 + ch * 8); }
            else { const int cc = c - 768, row = cc >> 3, ch = cc & 7; *(LAS v4u*)(Vt + row * VSTR + ch * 16) = *(const v4u*)(KNV + (size_t)(keyrow0 + k0 + row) * 768 + 384 + h * 64 + ch * 8); }
        }
        __syncthreads();
        attn_tile<3>(qf, Kt, KSTR_A, Vt, VSTR, sl2, m_, l_, O, lane);
    }
    const float il = 1.0f / l_;
#pragma unroll
    for (int dt = 0; dt < 4; ++dt) { v2u o; o.x = pk2(O[dt][0] * il, O[dt][1] * il); o.y = pk2(O[dt][2] * il, O[dt][3] * il);
        *(v2u*)(MIX + (size_t)trow * 1024 + h * 64 + 16 * dt + 4 * g) = o; }
}

__device__ __forceinline__ void diff_unit(Frame& F, int l, bool lat, int b, int h, int qt) {
    unsigned char* ws = F.ws; const bf16* QB = (const bf16*)(ws + WS_QB); const bf16* KB = (const bf16*)(ws + WS_KB); const bf16* VB = (const bf16*)(ws + WS_VB); bf16* MIX = (bf16*)(ws + WS_U);
    const int tok0 = lat ? MCTX + b * 1024 + qt * 128 : b * 256 + qt * 128, keyrow0 = lat ? MCTX + b * 1280 : b * 256, NK = lat ? 1280 : 256;
    const int lane = F.lane, r = lane & 15, g = lane >> 4; const int trow = tok0 + 16 * F.wave + r;
    bf16x8 q0[1], q1[1];
    q0[0] = *(const bf16x8*)(QB + (size_t)trow * 256 + h * 64 + 8 * g); q1[0] = *(const bf16x8*)(QB + (size_t)trow * 256 + h * 64 + 32 + 8 * g);
    float m0 = -1e30f, l0 = 0.f, m1 = -1e30f, l1 = 0.f; f32x4 O0[4], O1[4];
#pragma unroll
    for (int dt = 0; dt < 4; ++dt) { O0[dt] = (f32x4){0.f, 0.f, 0.f, 0.f}; O1[dt] = (f32x4){0.f, 0.f, 0.f, 0.f}; }
    LAS unsigned char* Kt = F.lds + ATT_K_OFF; LAS unsigned char* Vt = F.lds + ATT_V_OFF;
    const float sl2 = 0.17677669529663687f * 1.4426950408889634f;
    for (int k0 = 0; k0 < NK; k0 += 64) {
        __syncthreads();
        for (int c = F.tid; c < 1024; c += NTHR) {
            if (c < 512) { const int row = c >> 3, ch = c & 7; *(LAS v4u*)(Kt + row * KSTR_B + ch * 16) = *(const v4u*)(KB + (size_t)(keyrow0 + k0 + row) * 256 + h * 64 + ch * 8); }
            else { const int cc = c - 512, row = cc >> 3, ch = cc & 7; *(LAS v4u*)(Vt + row * VSTR + ch * 16) = *(const v4u*)(VB + (size_t)(keyrow0 + k0 + row) * 256 + h * 64 + ch * 8); }
        }
        __syncthreads();
        attn_tile<1>(q0, Kt, KSTR_B, Vt, VSTR, sl2, m0, l0, O0, lane);
        attn_tile<1>(q1, Kt + 64, KSTR_B, Vt, VSTR, sl2, m1, l1, O1, lane);
    }
    float d1 = 0.f, d2 = 0.f;
    #pragma unroll 4
    for (int i = 0; i < 32; ++i) { d1 += F.in[I_LQ1][l * 32 + i] * F.in[I_LK1][l * 32 + i]; d2 += F.in[I_LQ2][l * 32 + i] * F.in[I_LK2][l * 32 + i]; }
    const float lam = expf(d1) - expf(d2) + (l == 0 ? 0.2f : (0.8f - 0.6f * 0.7408182206817179f));
    const float i0 = 1.0f / l0, i1 = lam / l1;
#pragma unroll
    for (int dt = 0; dt < 4; ++dt) { v2u o; o.x = pk2(O0[dt][0] * i0 - O1[dt][0] * i1, O0[dt][1] * i0 - O1[dt][1] * i1); o.y = pk2(O0[dt][2] * i0 - O1[dt][2] * i1, O0[dt][3] * i0 - O1[dt][3] * i1);
        *(v2u*)(MIX + (size_t)trow * 1024 + 384 + h * 64 + 16 * dt + 4 * g) = o; }
}

constexpr int GL_GS = 0, GL_QE = 12288, GL_KE = 21504, GL_KDT = 30720, GL_VT = 37632, GL_ST = 51456, GL_AT = 65280, GL_STR = 144;
__device__ __forceinline__ void gla_unit(Frame& F, int l, bool lat, int b, int h, int dir) {
    unsigned char* ws = F.ws; const bf16* P = (const bf16*)(ws + WS_PH); bf16* MIX = (bf16*)(ws + WS_U); bf16* OCB = (bf16*)(ws + WS_OCB);
    const int N = lat ? 1024 : 256, nc = N / 64, tokbase = lat ? MCTX + b * 1024 : b * 256;
    const int lane = F.lane, r = lane & 15, g = lane >> 4, w = F.wave, tid = F.tid;
    LAS float* GS = (LAS float*)(F.lds + GL_GS);
    LAS unsigned char* QE = F.lds + GL_QE; LAS unsigned char* KE = F.lds + GL_KE; LAS unsigned char* KDT = F.lds + GL_KDT; LAS unsigned char* VT = F.lds + GL_VT; LAS unsigned char* ST = F.lds + GL_ST; LAS unsigned char* AT = F.lds + GL_AT;
    const float* wg = F.in[dir ? I_WGB : I_WGF] + l * 16 * 192; const float* bg = F.in[dir ? I_BGB : I_BGF] + l * 192;
    __syncthreads();
    for (int i = tid; i < (64 + 64 + 96) * 12; i += NTHR) { const int row = i / 12, c = i % 12; LAS unsigned char* base = row < 64 ? QE + row * GL_STR : (row < 128 ? KE + (row - 64) * GL_STR : ST + (row - 128) * GL_STR);
        *(LAS unsigned*)(base + 96 + c * 4) = 0u; }
    f32x4 S[3];
#pragma unroll
    for (int dt = 0; dt < 3; ++dt) S[dt] = (f32x4){0.f, 0.f, 0.f, 0.f};
    if (lat && w < 6) { const float* s0 = F.in[dir ? I_SB : I_SF] + (size_t)((b * 2 + l) * 4 + h) * 4608;
#pragma unroll
        for (int dt = 0; dt < 3; ++dt)
#pragma unroll
            for (int j = 0; j < 4; ++j) S[dt][j] = s0[(16 * dt + 4 * g + j) * 96 + 16 * w + r]; }
    if (w < 6) {
#pragma unroll
        for (int dt = 0; dt < 3; ++dt) { v2u o; o.x = pk2(S[dt][0], S[dt][1]); o.y = pk2(S[dt][2], S[dt][3]); *(LAS v2u*)(ST + (16 * w + r) * GL_STR + (16 * dt + 4 * g) * 2) = o; }
    }
    for (int c = 0; c < nc; ++c) {
        __syncthreads();
        for (int i = tid; i < 3072; i += NTHR) { const int s = i / 48, d = i % 48; const int pi = 64 * c + s; const int tok = tokbase + (dir ? N - 1 - pi : pi);
            const bf16* gl = P + (size_t)tok * PCOLS + PC_GLF + dir * 16; float x = bg[h * 48 + d];
#pragma unroll
            for (int q = 0; q < 16; ++q) x += bf2f(gl[q]) * wg[q * 192 + h * 48 + d];
            const float ls = fminf(x, 0.f) - log1pf(__expf(-fabsf(x)));
            GS[s * 48 + d] = ls * (1.0f / 16.0f); }
        __syncthreads();
        if (tid < 48) { float a = 0.f; for (int s = 0; s < 64; ++s) { a += GS[s * 48 + tid]; GS[s * 48 + tid] = a; } }
        __syncthreads();
        for (int i = tid; i < 3072; i += NTHR) { const int s = i / 48, d = i % 48; const int pi = 64 * c + s; const int tok = tokbase + (dir ? N - 1 - pi : pi);
            const float bc = GS[s * 48 + d], bl = GS[63 * 48 + d];
            const float qv = bf2f(P[(size_t)tok * PCOLS + PC_GQ + h * 48 + d]) * 0.14433756729740643f, kv = bf2f(P[(size_t)tok * PCOLS + PC_GK + h * 48 + d]);
            *(LAS bf16*)(QE + s * GL_STR + d * 2) = f2bf(qv * __expf(bc)); *(LAS bf16*)(KE + s * GL_STR + d * 2) = f2bf(kv * __expf(-bc)); *(LAS bf16*)(KDT + d * GL_STR + s * 2) = f2bf(kv * __expf(bl - bc)); }
        for (int i = tid; i < 6144; i += NTHR) { const int s = i / 96, v = i % 96; const int pi = 64 * c + s; const int tok = tokbase + (dir ? N - 1 - pi : pi);
            *(LAS bf16*)(VT + v * GL_STR + s * 2) = P[(size_t)tok * PCOLS + PC_GV + h * 96 + v]; }
        __syncthreads();
#pragma unroll
        for (int tl = 0; tl < 2; ++tl) { const int tile = 2 * w + tl, ti = tile >> 2, si = tile & 3; f32x4 cc = (f32x4){0.f, 0.f, 0.f, 0.f};
#pragma unroll
            for (int ks = 0; ks < 2; ++ks) { const bf16x8 a = *(LAS const bf16x8*)(KE + (16 * si + r) * GL_STR + (32 * ks + 8 * g) * 2); const bf16x8 bq = *(LAS const bf16x8*)(QE + (16 * ti + r) * GL_STR + (32 * ks + 8 * g) * 2); cc = mfma16(a, bq, cc); }
            const int tq = 16 * ti + r; float o[4];
#pragma unroll
            for (int j = 0; j < 4; ++j) o[j] = (16 * si + 4 * g + j <= tq) ? cc[j] : 0.f;
            v2u ow; ow.x = pk2(o[0], o[1]); ow.y = pk2(o[2], o[3]); *(LAS v2u*)(AT + tq * GL_STR + (16 * si + 4 * g) * 2) = ow; }
        if (w < 6) {
#pragma unroll
            for (int dt = 0; dt < 3; ++dt) { f32x4 u = (f32x4){0.f, 0.f, 0.f, 0.f};
#pragma unroll
                for (int ks = 0; ks < 2; ++ks) { const bf16x8 a = *(LAS const bf16x8*)(KDT + (16 * dt + r) * GL_STR + (32 * ks + 8 * g) * 2); const bf16x8 bv = *(LAS const bf16x8*)(VT + (16 * w + r) * GL_STR + (32 * ks + 8 * g) * 2); u = mfma16(a, bv, u); }
#pragma unroll
                for (int j = 0; j < 4; ++j) S[dt][j] = __expf(GS[63 * 48 + 16 * dt + 4 * g + j]) * S[dt][j] + u[j]; }
        }
        __syncthreads();
#pragma unroll
        for (int tl = 0; tl < 3; ++tl) { const int tile = w + 8 * tl, ti = tile / 6, vi = tile % 6; f32x4 cc = (f32x4){0.f, 0.f, 0.f, 0.f};
#pragma unroll
            for (int ks = 0; ks < 2; ++ks) { const bf16x8 a = *(LAS const bf16x8*)(VT + (16 * vi + r) * GL_STR + (32 * ks + 8 * g) * 2); const bf16x8 bq = *(LAS const bf16x8*)(AT + (16 * ti + r) * GL_STR + (32 * ks + 8 * g) * 2); cc = mfma16(a, bq, cc); }
#pragma unroll
            for (int ks = 0; ks < 2; ++ks) { const bf16x8 a = *(LAS const bf16x8*)(ST + (16 * vi + r) * GL_STR + (32 * ks + 8 * g) * 2); const bf16x8 bq = *(LAS const bf16x8*)(QE + (16 * ti + r) * GL_STR + (32 * ks + 8 * g) * 2); cc = mfma16(a, bq, cc); }
            const int pi = 64 * c + 16 * ti + r; const int tok = tokbase + (dir ? N - 1 - pi : pi);
            v2u ow; ow.x = pk2(cc[0], cc[1]); ow.y = pk2(cc[2], cc[3]);
            bf16* dst = dir ? OCB + (size_t)tok * 384 + h * 96 + 16 * vi + 4 * g : MIX + (size_t)tok * 1024 + 640 + h * 96 + 16 * vi + 4 * g;
            *(v2u*)dst = ow; }
        __syncthreads();
        if (w < 6) {
#pragma unroll
            for (int dt = 0; dt < 3; ++dt) { v2u o; o.x = pk2(S[dt][0], S[dt][1]); o.y = pk2(S[dt][2], S[dt][3]); *(LAS v2u*)(ST + (16 * w + r) * GL_STR + (16 * dt + 4 * g) * 2) = o; }
        }
    }
    if (!lat && w < 6) { float* so = F.out + (dir ? O_SB : O_SF) + (size_t)((b * 2 + l) * 4 + h) * 4608;
#pragma unroll
        for (int dt = 0; dt < 3; ++dt)
#pragma unroll
            for (int j = 0; j < 4; ++j) so[(16 * dt + 4 * g + j) * 96 + 16 * w + r] = S[dt][j]; }
}

constexpr int NU_GL = 64, NU_ML = 384, NU_DL = 256, NU_GC = 256, NU_MC = 384, NU_DC = 256, NU_ALL = NU_GL + NU_ML + NU_DL + NU_GC + NU_MC + NU_DC;
__device__ __forceinline__ void mixer_phase(Frame& F, int l) {
    LAS int* us = (LAS int*)(F.lds + 140000);
    unsigned* ctr = (unsigned*)(F.ws + WS_CTL) + 64 * l;
    for (;;) {
        __syncthreads();
        if (F.tid == 0) *us = (int)atomicAdd(ctr, 1u);
        __syncthreads();
        int u = *us; if (u >= NU_ALL) break;
        int type, lat, b, h, x;
        if (u < NU_GL) { type = 0; lat = 1; b = u >> 3; h = (u >> 1) & 3; x = u & 1; }
        else if ((u -= NU_GL) < NU_ML) { type = 1; lat = 1; b = u / 48; const int rr = u % 48; h = rr >> 3; x = rr & 7; }
        else if ((u -= NU_ML) < NU_DL) { type = 2; lat = 1; b = u >> 5; const int rr = u & 31; h = rr >> 3; x = rr & 7; }
        else if ((u -= NU_DL) < NU_GC) { type = 0; lat = 0; b = u >> 3; h = (u >> 1) & 3; x = u & 1; }
        else if ((u -= NU_GC) < NU_MC) { type = 1; lat = 0; b = u / 12; const int rr = u % 12; h = rr >> 1; x = rr & 1; }
        else { u -= NU_MC; type = 2; lat = 0; b = u >> 3; const int rr = u & 7; h = rr >> 1; x = rr & 1; }
        Frame F2 = F; { int t = F.tid; asm volatile("" : "+v"(t)); F2.tid = t; F2.lane = t & 63; F2.wave = __builtin_amdgcn_readfirstlane(t >> 6);
            unsigned char* w2 = F.ws; asm volatile("" : "+s"(w2)); F2.ws = w2; }
        if (type == 0) gla_unit(F2, l, lat != 0, b, h, x);
        else if (type == 1) mla_unit(F2, l, lat != 0, b, h, x);
        else diff_unit(F2, l, lat != 0, b, h, x);
    }
}

__device__ __forceinline__ void merge_phase(Frame& F, int l) {
    unsigned char* ws = F.ws; bf16* MIX = (bf16*)(ws + WS_U); const bf16* OCB = (const bf16*)(ws + WS_OCB); const bf16* P = (const bf16*)(ws + WS_PH);
    const float* on = F.in[I_ONORM] + l * 384; const float* dn = F.in[I_DNORM] + l * 64; const float* gn = F.in[I_GNORM] + l * 96;
    const float oml = 1.0f - (l == 0 ? 0.2f : (0.8f - 0.6f * 0.7408182206817179f));
    const int lane = F.lane;
    for (int m = F.gw; m < MTOK; m += F.ngw) {
        bf16* row = MIX + (size_t)m * 1024;
        unsigned wa[3], wb[2], wc[3], wd[3], wr_[3];
#pragma unroll
        for (int j = 0; j < 3; ++j) { wa[j] = *(const unsigned*)(row + lane * 6 + 2 * j); wc[j] = *(const unsigned*)(row + 640 + lane * 6 + 2 * j); wd[j] = *(const unsigned*)(OCB + (size_t)m * 384 + lane * 6 + 2 * j);
            wr_[j] = *(const unsigned*)(P + (size_t)m * PCOLS + PC_RC + lane * 6 + 2 * j); }
        { const v2u t = *(const v2u*)(row + 384 + lane * 4); wb[0] = t.x; wb[1] = t.y; }
        float xa[6], xb[4], xc[6]; float sa = 0.f, sb = 0.f, sc = 0.f;
#pragma unroll
        for (int j = 0; j < 3; ++j) { xa[2 * j] = bflo(wa[j]); xa[2 * j + 1] = bfhi(wa[j]); xc[2 * j] = bflo(wc[j]) + bflo(wd[j]); xc[2 * j + 1] = bfhi(wc[j]) + bfhi(wd[j]); }
#pragma unroll
        for (int j = 0; j < 2; ++j) { xb[2 * j] = bflo(wb[j]); xb[2 * j + 1] = bfhi(wb[j]); }
#pragma unroll
        for (int e = 0; e < 6; ++e) { sa += xa[e] * xa[e]; sc += xc[e] * xc[e]; }
#pragma unroll
        for (int e = 0; e < 4; ++e) sb += xb[e] * xb[e];
        const float ra = rsqrtf(wave_sum(sa) * (1.0f / 384.0f) + EPS), rb = rsqrtf(grp16_sum(sb) * (1.0f / 64.0f) + EPS) * oml, rc = rsqrtf(grp16_sum(sc) * (1.0f / 96.0f) + EPS);
        float ya[6], yb[4], yc[6];
#pragma unroll
        for (int e = 0; e < 6; ++e) { ya[e] = xa[e] * ra * on[lane * 6 + e];
            const float rv = (e & 1) ? bfhi(wr_[e >> 1]) : bflo(wr_[e >> 1]); const float sg = rv / (1.0f + __expf(-rv));
            yc[e] = xc[e] * rc * gn[(lane & 15) * 6 + e] * sg; }
#pragma unroll
        for (int e = 0; e < 4; ++e) yb[e] = xb[e] * rb * dn[(lane & 15) * 4 + e];
#pragma unroll
        for (int j = 0; j < 3; ++j) { *(unsigned*)(row + lane * 6 + 2 * j) = pk2(ya[2 * j], ya[2 * j + 1]); *(unsigned*)(row + 640 + lane * 6 + 2 * j) = pk2(yc[2 * j], yc[2 * j + 1]); }
        { v2u o; o.x = pk2(yb[0], yb[1]); o.y = pk2(yb[2], yb[3]); *(v2u*)(row + 384 + lane * 4) = o; }
    }
}

__global__ void __launch_bounds__(NTHR, 2) mega_fwd(Args args) {
    extern __shared__ __attribute__((aligned(16))) unsigned char lds_raw[];
    cg::grid_group grid = cg::this_grid();
    Frame F;
    F.lds = (LAS unsigned char*)lds_raw;
    F.tid = threadIdx.x; F.lane = F.tid & 63; F.wave = __builtin_amdgcn_readfirstlane(F.tid >> 6);
    F.G = gridDim.x; F.gw = blockIdx.x * NWAVES + F.wave; F.ngw = F.G * NWAVES;
    inptr_t kin = (inptr_t)__builtin_amdgcn_kernarg_segment_ptr();
    asm volatile("" : "+s"(kin));
    F.in = kin; F.out = (float*)kin[N_IN]; F.ws = (unsigned char*)kin[N_IN + 1];
    unsigned char* ws = F.ws;
    float* X = F.out + O_X;
    bf16* U = (bf16*)(ws + WS_U); bf16* PH = (bf16*)(ws + WS_PH);
    const float* MOD = (const float*)(ws + WS_MOD);
    const int bx = (int)blockIdx.x;

#pragma unroll 1
    for (int st = 0; st < 28; ++st) {
        const int l = st / 14, k = st % 14;
        { int t = threadIdx.x; asm volatile("" : "+v"(t)); F.tid = t; F.lane = t & 63; F.wave = __builtin_amdgcn_readfirstlane(t >> 6); F.gw = blockIdx.x * NWAVES + F.wave;
          asm volatile("" : "+s"(kin)); F.in = kin; F.out = (float*)kin[N_IN]; X = F.out + O_X;
          unsigned char* w2 = (unsigned char*)kin[N_IN + 1]; asm volatile("" : "+s"(w2)); F.ws = w2; ws = w2; U = (bf16*)(ws + WS_U); PH = (bf16*)(ws + WS_PH); MOD = (const float*)(ws + WS_MOD); }
        const float* modl = MOD + (size_t)l * 9 * 9216;
        const bool first = (l == 0 && k <= 3);
        const float* xc = first ? F.in[I_XP] : X; const float* xl = first ? F.in[I_XS] : X + (size_t)MCTX * D;
        if (k == 0) { prep_phase(F, l); }
        else if (k == 1 || k == 4 || k == 11) { const int ni = k == 1 ? 0 : (k == 4 ? 1 : 2);
            norm_phase(F, xc, xl, F.in[k == 1 ? I_NF1 : (k == 4 ? I_NMIX : I_NF2)] + l * D, modl, ni, U); }
        else if (k == 2 || k == 12) { pg8::Gemm g{U, (const bf16*)(ws + (k == 2 ? WS_WT13A : WS_WT13B)), MTOK, 2 * DFF, D}; pg8::StaticOrder S; S.init(MTOK, 2 * DFF, F.G, bx); pg8::EpiSwiglu E{PH, DFF};
            pg8::gemm_phase<pg8::EpiSwiglu, pg8::StaticOrder, true, true>(F.lds, g, S, E); }
        else if (k == 3 || k == 10 || k == 13) {
            const bf16* A = k == 10 ? U : PH; const bf16* Bt = (const bf16*)(ws + (k == 3 ? WS_WT2A : (k == 10 ? WS_WTOUT : WS_WT2B))); const int K = k == 10 ? D : DFF;
            const int gi = k == 3 ? 2 : (k == 10 ? 5 : 8); const float gs = k == 10 ? 1.0f : 0.5f;
            pg8::Gemm g{A, Bt, MTOK, D, K}; pg8::StaticOrder S; S.init(MTOK, D, F.G, bx); pg8::EpiResid E{xc, xl, X, modl + gi * 1024, gs};
            pg8::gemm_phase<pg8::EpiResid, pg8::StaticOrder, true, true>(F.lds, g, S, E); }
        else if (k == 5 || k == 7) {
            const int nj = k == 7 ? 2 : 1;
#pragma unroll 1
            for (int j = 0; j < nj; ++j) {
                const bf16* A = k == 5 ? U : (const bf16*)(ws + (j == 0 ? WS_CQN : WS_CKV)); const bf16* Bt = (const bf16*)(ws + (k == 5 ? WS_WTIN : (j == 0 ? WS_WTUQ : WS_WTUKV)));
                bf16* O = k == 5 ? PH : (bf16*)(ws + (j == 0 ? WS_QA : WS_KNV));
                const int M = (k == 7 && j == 1) ? NKEYROWS : MTOK, N = k == 5 ? PCOLS : 768, K = k == 5 ? D : (j == 0 ? 384 : 256);
                pg8::Gemm g{A, Bt, M, N, K}; pg8::StaticOrder S; S.init(M, N, F.G, (bx + 64 * j) % F.G); pg8::EpiBf16P E{O, N};
                pg8::gemm_phase<pg8::EpiBf16P, pg8::StaticOrder, true, true>(F.lds, g, S, E); } }
        else if (k == 6) postproj_phase(F, l);
        else if (k == 8) mixer_phase(F, l);
        else merge_phase(F, l);
        grid.sync();
    }
    final_norm_phase(F, X, F.in[I_FNORM]);
}

extern "C" void kernel_launch(void* const* d_in, const int* in_sizes, int n_in, void* d_out, int out_size, void* d_ws, size_t ws_size, hipStream_t stream) {
    static int grid = 0;
    if (grid == 0) {
        if (n_in != N_IN || ws_size < WS_END) { fprintf(stderr, "kernel_launch: unexpected n_in %d or ws_size %zu\n", n_in, ws_size); grid = -1; return; }
        int dev = 0, cus = 0, per_cu = 0;
        hipGetDevice(&dev); hipDeviceGetAttribute(&cus, hipDeviceAttributeMultiprocessorCount, dev);
        if (hipFuncSetAttribute((const void*)mega_fwd, hipFuncAttributeMaxDynamicSharedMemorySize, LDS_BYTES) != hipSuccess) fprintf(stderr, "kernel_launch: hipFuncSetAttribute failed\n");
        if (hipOccupancyMaxActiveBlocksPerMultiprocessor(&per_cu, (const void*)mega_fwd, NTHR, LDS_BYTES) != hipSuccess || per_cu < 1) { fprintf(stderr, "kernel_launch: occupancy query gave %d\n", per_cu); per_cu = 1; }
        (void)hipGetLastError();
        grid = cus * per_cu;
    }
    if (grid < 0) return;
    hipMemsetAsync((char*)d_ws + WS_CTL, 0, 4096, stream);
    Args a{};
    for (int i = 0; i < N_IN; ++i) a.in[i] = (const float*)d_in[i];
    a.out = (float*)d_out; a.ws = (unsigned char*)d_ws;
    void* kargs[] = {&a};
    hipError_t e = hipLaunchCooperativeKernel((const void*)mega_fwd, dim3(grid), dim3(NTHR), kargs, LDS_BYTES, stream);
    if (e != hipSuccess) fprintf(stderr, "kernel_launch: cooperative launch failed: %s (grid %d)\n", hipGetErrorString(e), grid);
}
```

```cpp
#include <hip/hip_runtime.h>
#include <hip/hip_cooperative_groups.h>
#include <cstdio>
#include <cstdint>
namespace cg = cooperative_groups;
#ifndef PROBE_MIXER2
#define PROBE_MIXER2 0
#endif
#ifndef PROBE_SYNC2
#define PROBE_SYNC2 0
#endif
namespace pg8 {
#define PG8_LAS __attribute__((address_space(3)))
typedef unsigned short bf16_t;
typedef short bf16x8 __attribute__((ext_vector_type(8)));
typedef float f32x4 __attribute__((ext_vector_type(4)));
typedef unsigned u32x4 __attribute__((ext_vector_type(4)));
constexpr int BM = 256, BK = 64, HALF = 128, HTB = HALF * BK * 2  , STAGE_BYTES = 8 * HTB, NXCD = 8, WGM = 8;

__host__ __device__ __forceinline__ int lds_byte(int r, int c) { const int st = (r >> 4) * 2 + (c >> 5), rr = r & 15, cc = c & 31, ob = rr * 64 + cc * 2; return st * 1024 + (ob ^ (((ob >> 9) & 1) << 5)); }
__host__ __device__ __forceinline__ void stage_rc(int b, int& R, int& C) { const int st = b / 1024, sb = b % 1024, swz = sb ^ (((sb >> 9) & 1) << 5); R = (st >> 1) * 16 + swz / 64; C = (st & 1) * 32 + (swz % 64) / 2; }
__host__ __device__ __forceinline__ int perm32(int rho) { const int n = rho >> 4, i = rho & 15; return 8 * (i >> 2) + 4 * n + (i & 3); }

struct Unit { int pm, pn; };
struct Gemm { const bf16_t* A; const bf16_t* Bt; int M, N, K; };

struct StaticOrder {
    int nM, nN, nwg, G, c;
    __host__ __device__ void init(int M, int N, int G_, int c_) { nM = M / BM; nN = N / BM; nwg = nM * nN; G = G_; c = c_; }
    __host__ __device__ bool next(int i, Unit& u) const {
        const long L = (long)i * G + c; if (L >= nwg) return false;
        int wgid = (int)L; { const int q = nwg / NXCD, r = nwg % NXCD, xcd = wgid % NXCD, off = wgid / NXCD; wgid = (xcd < r ? xcd * (q + 1) : r * (q + 1) + (xcd - r) * q) + off; }
        const int nig = WGM * nN, gid = wgid / nig, fm = gid * WGM, gsz = (nM - fm) < WGM ? (nM - fm) : WGM;
        u.pm = fm + ((wgid % nig) % gsz); u.pn = (wgid % nig) / gsz; return true;
    }
    __device__ __forceinline__ void a_ready(const Unit&) const {}
    __device__ __forceinline__ void done(const Unit&) const {}
};

__device__ __forceinline__ unsigned cvt_pk_bf16(float lo, float hi) { unsigned r; asm volatile("v_cvt_pk_bf16_f32 %0, %1, %2" : "=v"(r) : "v"(lo), "v"(hi)); return r; }
struct EpiSwiglu {
    static constexpr bool PERM = true, AFTER_DRAIN = false;
    bf16_t* O; int ldc;
    __device__ __forceinline__ void operator()(const f32x4 (&acc)[2][2][4][2], const Unit& u, int wr, int wc, int fr, int fq) const {
        const int row0 = u.pm * BM + wr * 64 + fr; const int col0 = u.pn * HALF + wc * 32 + 8 * fq;
#pragma unroll
        for (int ai = 0; ai < 2; ++ai)
#pragma unroll
            for (int m = 0; m < 4; ++m) {
                bf16_t* rowp = O + (size_t)(row0 + ai * HALF + m * 16) * ldc + col0;
                float r[8];
#pragma unroll
                for (int n = 0; n < 2; ++n)
#pragma unroll
                    for (int e = 0; e < 4; ++e) { const float a = acc[ai][0][m][n][e], b = acc[ai][1][m][n][e];
                        const float s = a * __builtin_amdgcn_rcpf(1.0f + __builtin_amdgcn_exp2f(-1.4426950408889634f * a)); r[n * 4 + e] = s * b; }
                u32x4 w; w.x = cvt_pk_bf16(r[0], r[1]); w.y = cvt_pk_bf16(r[2], r[3]); w.z = cvt_pk_bf16(r[4], r[5]); w.w = cvt_pk_bf16(r[6], r[7]);
                *(u32x4*)rowp = w;
            }
    }
};
struct EpiResid {
    static constexpr bool PERM = false, AFTER_DRAIN = false;
    const float* xin_ctx; const float* xin_lat; float* out; const float* gate_base; float gs;
    __device__ __forceinline__ void operator()(const f32x4 (&acc)[2][2][4][2], const Unit& u, int wr, int wc, int fr, int fq) const {
        const int bk = u.pm < 32 ? 0 : 1 + ((u.pm - 32) >> 2);
        const float* gate = gate_base + bk * 9216;
        const float* xin = u.pm < 32 ? xin_ctx : xin_lat; const size_t xoff = u.pm < 32 ? 0 : (size_t)8192 * 1024;
        const int col0 = u.pn * BM + wc * 32 + 4 * fq;
#pragma unroll
        for (int bj = 0; bj < 2; ++bj)
#pragma unroll
            for (int n = 0; n < 2; ++n) {
                const f32x4 gv = *(const f32x4*)(gate + col0 + bj * HALF + n * 16) * gs;
#pragma unroll
                for (int ai = 0; ai < 2; ++ai)
#pragma unroll
                    for (int m = 0; m < 4; ++m) {
                        const size_t off = (size_t)(u.pm * BM + ai * HALF + wr * 64 + m * 16 + fr) * 1024 + col0 + bj * HALF + n * 16;
                        const f32x4 xv = *(const f32x4*)(xin + (off - xoff));
                        *(f32x4*)(out + off) = xv + gv * acc[ai][bj][m][n];
                    }
            }
    }
};
struct EpiBf16P {
    static constexpr bool PERM = true, AFTER_DRAIN = false;
    bf16_t* O; int ldc;
    __device__ __forceinline__ void operator()(const f32x4 (&acc)[2][2][4][2], const Unit& u, int wr, int wc, int fr, int fq) const {
        const int row0 = u.pm * BM + wr * 64 + fr; const int col0 = u.pn * BM + wc * 32 + 8 * fq;
#pragma unroll
        for (int ai = 0; ai < 2; ++ai)
#pragma unroll
            for (int m = 0; m < 4; ++m) {
                bf16_t* rowp = O + (size_t)(row0 + ai * HALF + m * 16) * ldc + col0;
#pragma unroll
                for (int bj = 0; bj < 2; ++bj) { const f32x4 v0 = acc[ai][bj][m][0], v1 = acc[ai][bj][m][1];
                    u32x4 w; w.x = cvt_pk_bf16(v0[0], v0[1]); w.y = cvt_pk_bf16(v0[2], v0[3]); w.z = cvt_pk_bf16(v1[0], v1[1]); w.w = cvt_pk_bf16(v1[2], v1[3]);
                    *(u32x4*)(rowp + bj * HALF) = w; }
            }
    }
};
template <class Epi, class Sched, bool ALIGN_EPI = false, bool SP2 = false>
__device__ __forceinline__ void gemm_phase(PG8_LAS unsigned char* lds, const Gemm g, const Sched& S, const Epi& E) {
    int tid_ = threadIdx.x; asm volatile("" : "+v"(tid_));
    const int tid = tid_, wid = __builtin_amdgcn_readfirstlane(tid >> 6), lane = tid & 63, wr = wid >> 2, wc = wid & 3, fr = lane & 15, fq = lane >> 4;
    const int K = g.K, nt = K / BK;
    unsigned voffA[2], voffB[2];
#pragma unroll
    for (int i = 0; i < 2; ++i) { int R, C; stage_rc(tid * 16 + i * 8192, R, C); const int Rb = Epi::PERM ? ((R & ~31) + perm32(R & 31)) : R;
        voffA[i] = (unsigned)(R * K + C) * 2u; voffB[i] = (unsigned)(Rb * K + C) * 2u; }
    const size_t kstep = (size_t)(BK * 2);
    const size_t hstep = (size_t)HALF * K * 2;
    const size_t tstep = 2 * hstep;
    const unsigned ldsw = (unsigned)wid * 1024u;
    const int aoff = lds_byte(wr * 64 + fr, fq * 8), boff = lds_byte(wc * 32 + fr, fq * 8);
#define PG8_SA(b, h) (((b) * 2 + (h)) * HTB)
#define PG8_SB(b, h) ((4 + (b) * 2 + (h)) * HTB)
#define PG8_STAGE(bufoff, gbase, voff) do { _Pragma("unroll") for (int _i = 0; _i < 2; ++_i) \
        __builtin_amdgcn_global_load_lds((const unsigned*)((const char*)(gbase) + (voff)[_i]), (PG8_LAS unsigned*)(lds + (bufoff) + ldsw + _i * 8192), 16, 0, 0); } while (0)
#define PG8_LDA(dst, b, h) do { _Pragma("unroll") for (int m = 0; m < 4; ++m) _Pragma("unroll") for (int k = 0; k < 2; ++k) dst[m][k] = *(const PG8_LAS bf16x8*)(lds + PG8_SA(b, h) + aoff + m * 2048 + k * 1024); } while (0)
#define PG8_LDB(dst, b, h) do { _Pragma("unroll") for (int n = 0; n < 2; ++n) _Pragma("unroll") for (int k = 0; k < 2; ++k) dst[n][k] = *(const PG8_LAS bf16x8*)(lds + PG8_SB(b, h) + boff + n * 2048 + k * 1024); } while (0)
#define PG8_MMA(ai, bj, At, Bt) do { __builtin_amdgcn_s_setprio(1); _Pragma("unroll") for (int m = 0; m < 4; ++m) _Pragma("unroll") for (int n = 0; n < 2; ++n) _Pragma("unroll") for (int k = 0; k < 2; ++k) \
        acc[ai][bj][m][n] = __builtin_amdgcn_mfma_f32_16x16x32_bf16(Bt[n][k], At[m][k], acc[ai][bj][m][n], 0, 0, 0); __builtin_amdgcn_s_setprio(0); } while (0)
#define PG8_WAIT_V(n) asm volatile("s_waitcnt vmcnt(" #n ")" ::: "memory")
#define PG8_WAIT_L(n) asm volatile("s_waitcnt lgkmcnt(" #n ")" ::: "memory")
#define PG8_BAR __builtin_amdgcn_s_barrier()
#define PG8_SCHED __builtin_amdgcn_sched_barrier(0)
    Unit cur, nxt; int ui = 0;
    if (!S.next(0, cur)) return;
    f32x4 acc[2][2][4][2];
#pragma unroll
    for (int a = 0; a < 2; ++a)
#pragma unroll
        for (int b = 0; b < 2; ++b)
#pragma unroll
            for (int m = 0; m < 4; ++m)
#pragma unroll
                for (int n = 0; n < 2; ++n) acc[a][b][m][n] = (f32x4){0.f, 0.f, 0.f, 0.f};
    bf16x8 At[4][2], B0[2][2], B1[2][2];
    const char* cA = (const char*)g.A + (size_t)cur.pm * tstep; const char* cB = (const char*)g.Bt + (size_t)cur.pn * tstep;
    S.a_ready(cur);
    if constexpr (SP2) {
        PG8_STAGE(PG8_SB(0, 0), cB, voffB); PG8_STAGE(PG8_SB(0, 1), cB + hstep, voffB); PG8_STAGE(PG8_SA(0, 0), cA, voffA); PG8_STAGE(PG8_SA(0, 1), cA + hstep, voffA);
        if (wr == 1) PG8_BAR;
        PG8_WAIT_V(2); PG8_BAR;
        PG8_STAGE(PG8_SB(1, 0), cB + kstep, voffB); PG8_STAGE(PG8_SA(1, 0), cA + kstep, voffA); PG8_STAGE(PG8_SB(1, 1), cB + hstep + kstep, voffB);
        PG8_WAIT_V(6); PG8_BAR;
    } else {
        PG8_STAGE(PG8_SB(0, 0), cB, voffB); PG8_STAGE(PG8_SA(0, 0), cA, voffA); PG8_STAGE(PG8_SB(0, 1), cB + hstep, voffB); PG8_STAGE(PG8_SA(0, 1), cA + hstep, voffA);
        if (wr == 1) PG8_BAR;
        PG8_WAIT_V(4); PG8_BAR;
        PG8_STAGE(PG8_SB(1, 0), cB + kstep, voffB); PG8_STAGE(PG8_SA(1, 0), cA + kstep, voffA); PG8_STAGE(PG8_SB(1, 1), cB + hstep + kstep, voffB);
        PG8_WAIT_V(6); PG8_BAR;
    }
    for (;;) {
        const bool has_next = S.next(ui + 1, nxt);
        const char* nA = has_next ? (const char*)g.A + (size_t)nxt.pm * tstep : cA; const char* nB = has_next ? (const char*)g.Bt + (size_t)nxt.pn * tstep : cB;
        for (int t = 0; t < nt; t += 2) {
            const bool last = (t == nt - 2);
            const char* a1 = cA + (size_t)(t + 1) * kstep;
            const char* a2 = last ? nA : cA + (size_t)(t + 2) * kstep; const char* b2 = last ? nB : cB + (size_t)(t + 2) * kstep;
            const char* a3 = a2 + kstep; const char* b3 = b2 + kstep;
            if (last && has_next) S.a_ready(nxt);
            if constexpr (SP2) {
            PG8_LDB(B0, 0, 0); PG8_LDB(B1, 0, 1); PG8_SCHED; PG8_LDA(At, 0, 0); PG8_STAGE(PG8_SA(1, 1), a1 + hstep, voffA);
            PG8_WAIT_V(8); PG8_WAIT_L(0); PG8_BAR; PG8_MMA(0, 0, At, B0); PG8_MMA(0, 1, At, B1); PG8_BAR; PG8_SCHED;
            PG8_LDA(At, 0, 1); PG8_STAGE(PG8_SB(0, 0), b2, voffB); PG8_STAGE(PG8_SB(0, 1), b2 + hstep, voffB); PG8_STAGE(PG8_SA(0, 0), a2, voffA);
            PG8_WAIT_V(8); PG8_WAIT_L(0); PG8_BAR; PG8_MMA(1, 0, At, B0); PG8_MMA(1, 1, At, B1); PG8_BAR; PG8_SCHED;
            PG8_LDB(B0, 1, 0); PG8_LDB(B1, 1, 1); PG8_SCHED; PG8_LDA(At, 1, 0); PG8_STAGE(PG8_SA(0, 1), a2 + hstep, voffA);
            PG8_WAIT_V(8); PG8_WAIT_L(0); PG8_BAR; PG8_MMA(0, 0, At, B0); PG8_MMA(0, 1, At, B1); PG8_BAR; PG8_SCHED;
            PG8_LDA(At, 1, 1); PG8_STAGE(PG8_SB(1, 0), b3, voffB); PG8_STAGE(PG8_SB(1, 1), b3 + hstep, voffB); PG8_STAGE(PG8_SA(1, 0), a3, voffA);
            PG8_WAIT_V(8); PG8_WAIT_L(0); PG8_BAR; PG8_MMA(1, 0, At, B0); PG8_MMA(1, 1, At, B1); PG8_BAR; PG8_SCHED;
            } else {
            PG8_LDB(B0, 0, 0); PG8_SCHED; PG8_LDA(At, 0, 0); PG8_STAGE(PG8_SA(1, 1), a1 + hstep, voffA);
            PG8_WAIT_L(8); PG8_BAR; PG8_WAIT_L(0); PG8_MMA(0, 0, At, B0); PG8_BAR; PG8_SCHED;
            PG8_LDB(B1, 0, 1); PG8_STAGE(PG8_SB(0, 0), b2, voffB);
            PG8_BAR; PG8_WAIT_L(0); PG8_MMA(0, 1, At, B1); PG8_BAR;
            PG8_LDA(At, 0, 1); PG8_STAGE(PG8_SA(0, 0), a2, voffA);
            PG8_BAR; PG8_WAIT_L(0); PG8_MMA(1, 0, At, B0); PG8_BAR; PG8_SCHED;
            PG8_STAGE(PG8_SB(0, 1), b2 + hstep, voffB);
            PG8_WAIT_V(6); PG8_BAR; PG8_MMA(1, 1, At, B1); PG8_BAR;
            PG8_LDB(B0, 1, 0); PG8_SCHED; PG8_LDA(At, 1, 0); PG8_STAGE(PG8_SA(0, 1), a2 + hstep, voffA);
            PG8_WAIT_L(8); PG8_BAR; PG8_WAIT_L(0); PG8_MMA(0, 0, At, B0); PG8_BAR; PG8_SCHED;
            PG8_LDB(B1, 1, 1); PG8_STAGE(PG8_SB(1, 0), b3, voffB);
            PG8_BAR; PG8_WAIT_L(0); PG8_MMA(0, 1, At, B1); PG8_BAR;
            PG8_LDA(At, 1, 1); PG8_STAGE(PG8_SA(1, 0), a3, voffA);
            PG8_BAR; PG8_WAIT_L(0); PG8_MMA(1, 0, At, B0); PG8_BAR; PG8_SCHED;
            PG8_STAGE(PG8_SB(1, 1), b3 + hstep, voffB);
            PG8_WAIT_V(6); PG8_BAR; PG8_MMA(1, 1, At, B1); PG8_BAR;
            }
        }
        if constexpr (ALIGN_EPI) { if (wr == 0) PG8_BAR; }
        if constexpr (!Epi::AFTER_DRAIN) { E(acc, cur, wr, wc, fr, fq); S.done(cur); }
        if (!has_next) break;
#pragma unroll
        for (int a = 0; a < 2; ++a)
#pragma unroll
            for (int b = 0; b < 2; ++b)
#pragma unroll
                for (int m = 0; m < 4; ++m)
#pragma unroll
                    for (int n = 0; n < 2; ++n) acc[a][b][m][n] = (f32x4){0.f, 0.f, 0.f, 0.f};
        cur = nxt; cA = nA; cB = nB; ++ui;
        if constexpr (ALIGN_EPI) { if (wr == 1) PG8_BAR; }
    }
    PG8_WAIT_V(0);
    if constexpr (!ALIGN_EPI) { if (wr == 0) PG8_BAR; }
    PG8_BAR;
    if constexpr (Epi::AFTER_DRAIN) { E.fused(acc, cur, wr, wc, fr, fq, lds, wid, lane); S.done(cur); }
#undef PG8_SA
#undef PG8_SB
#undef PG8_STAGE
#undef PG8_LDA
#undef PG8_LDB
#undef PG8_MMA
#undef PG8_WAIT_V
#undef PG8_WAIT_L
#undef PG8_BAR
#undef PG8_SCHED
}
}
#define LAS __attribute__((address_space(3)))
typedef unsigned short bf16;
typedef unsigned v4u __attribute__((ext_vector_type(4)));
typedef unsigned v2u __attribute__((ext_vector_type(2)));
typedef float f32x4 __attribute__((ext_vector_type(4)));
typedef short bf16x8 __attribute__((ext_vector_type(8)));
typedef short s16x4 __attribute__((ext_vector_type(4)));

constexpr int NWAVES = 8, NTHR = 512;
constexpr int LDS_BYTES = 147456;
constexpr int D = 1024, MTOK = 16384, MCTX = 8192, NKEYROWS = 18432, DFF = 2816, PCOLS = 2816;
constexpr float EPS = 1e-6f;
constexpr size_t MiB = 1u << 20;
constexpr size_t WS_CTL = 0, WS_MOD = 1 * MiB, WS_ROPE = 1 * MiB + 768 * 1024;
constexpr size_t WS_WT13A = 2 * MiB, WS_WT13B = 13 * MiB, WS_WT2A = 24 * MiB, WS_WT2B = 24 * MiB + 5632 * 1024, WS_WTIN = 35 * MiB;
constexpr size_t WS_WTUQ = 40 * MiB + 512 * 1024, WS_WTUKV = 41 * MiB + 256 * 1024, WS_WTOUT = 42 * MiB;
constexpr size_t WS_PH = 44 * MiB, WS_U = 132 * MiB, WS_CQN = 164 * MiB, WS_CKV = 176 * MiB, WS_KR = 185 * MiB, WS_KB = 187 * MiB, WS_VB = 196 * MiB;
constexpr size_t WS_QB = 205 * MiB, WS_QA = 213 * MiB, WS_KNV = 237 * MiB, WS_OCB = 264 * MiB, WS_END = 276 * MiB;
constexpr size_t O_X = 0, O_CKV = 16777216, O_KR = 20971520, O_DK = 21495808, O_DV = 25690112, O_SF = 29884416, O_SB = 31064064;
constexpr int PC_CQ = 0, PC_CKV = 384, PC_KR = 640, PC_QB = 672, PC_KB = 928, PC_VB = 1184, PC_GQ = 1440, PC_GK = 1632, PC_GV = 1824, PC_RC = 2208, PC_GLF = 2592;

enum { I_XP = 0, I_XS, I_CCKV, I_CKR, I_CDK, I_CDV, I_SF, I_SB, I_C, I_CCTX, I_WMOD, I_BMOD, I_NF1, I_F1W13, I_F1W2, I_NMIX, I_WIN, I_QNORM, I_WUQ, I_KVNORM,
       I_WUK, I_WUV, I_ONORM, I_LQ1, I_LK1, I_LQ2, I_LK2, I_DNORM, I_WGF, I_BGF, I_WGB, I_BGB, I_GNORM, I_WOUT, I_NF2, I_F2W13, I_F2W2, I_FNORM, N_IN };

struct Args { const float* in[N_IN]; float* out; unsigned char* ws; };

__device__ __forceinline__ float bf2f(unsigned short h) { return __uint_as_float((unsigned)h << 16); }
__device__ __forceinline__ float bflo(unsigned w) { return __uint_as_float(w << 16); }
__device__ __forceinline__ float bfhi(unsigned w) { return __uint_as_float(w & 0xffff0000u); }
__device__ __forceinline__ unsigned pk2(float lo, float hi) { return pg8::cvt_pk_bf16(lo, hi); }
__device__ __forceinline__ unsigned short f2bf(float f) { return (unsigned short)(pk2(f, 0.f) & 0xffffu); }
__device__ __forceinline__ float wave_sum(float v) {
#pragma unroll
    for (int o = 1; o < 64; o <<= 1) v += __shfl_xor(v, o);
    return v;
}
__device__ __forceinline__ float grp16_sum(float v) {
#pragma unroll
    for (int o = 1; o < 16; o <<= 1) v += __shfl_xor(v, o);
    return v;
}
__device__ __forceinline__ f32x4 mfma16(bf16x8 a, bf16x8 b, f32x4 c) { return __builtin_amdgcn_mfma_f32_16x16x32_bf16(a, b, c, 0, 0, 0); }
typedef short v4i16_t __attribute__((ext_vector_type(4)));
__device__ __forceinline__ s16x4 vtr(LAS const unsigned char* p) { return __builtin_bit_cast(s16x4, __builtin_amdgcn_ds_read_tr16_b64_v4i16((LAS v4i16_t*)p)); }

typedef const float* cfp_t;
typedef __attribute__((address_space(4))) const cfp_t* inptr_t;
struct Frame {
    LAS unsigned char* lds;
    int tid, lane, wave, G, gw, ngw;
    inptr_t in; float* out; unsigned char* ws;
};

__device__ __forceinline__ void transpose_item(const float* W, int K, int N, bf16* WT, int row_off, LAS float* scr, int kb, int nb, int lane) {
    const int k0 = 64 * kb, n0 = 32 * nb;
#pragma unroll 8
    for (int i = 0; i < 32; ++i) { const int kk = 2 * i + (lane >> 5); scr[kk * 33 + (lane & 31)] = W[(size_t)(k0 + kk) * N + n0 + (lane & 31)]; }
    asm volatile("s_waitcnt lgkmcnt(0)" ::: "memory");
    const int c = lane & 7;
#pragma unroll
    for (int j = 0; j < 4; ++j) { const int n = (lane >> 3) + 8 * j; const LAS float* s = scr + (8 * c) * 33 + n;
        v4u o; o.x = pk2(s[0 * 33], s[1 * 33]); o.y = pk2(s[2 * 33], s[3 * 33]); o.z = pk2(s[4 * 33], s[5 * 33]); o.w = pk2(s[6 * 33], s[7 * 33]);
        *(v4u*)(WT + (size_t)(row_off + n0 + n) * K + k0 + 8 * c) = o; }
    asm volatile("s_waitcnt lgkmcnt(0)" ::: "memory");
}

__device__ __forceinline__ void prep_phase(Frame& F, int l) {
    LAS float* scr = (LAS float*)(F.lds + F.wave * 8704);
    unsigned char* ws = F.ws;
    constexpr int I13 = 16 * 176, I2 = 44 * 32, IIN = 16 * 82, IUQ = 6 * 18, IUK = 4 * 12, IOUT = 16 * 32;
    constexpr int NIT = 2 * I13 + 2 * I2 + IIN + IUQ + 2 * IUK + IOUT;
    for (int it = F.gw; it < NIT; it += F.ngw) {
        int r = it;
        if (r < 2 * I13) { const int f = r >= I13; r -= f * I13; const int kb = r / 176, nb = r % 176; const int n0 = 32 * nb; const int half = n0 >= DFF; const int j = n0 - half * DFF;
            const int orow = 256 * (j >> 7) + 128 * half + (j & 127);
            transpose_item(F.in[f ? I_F2W13 : I_F1W13] + (size_t)l * 1024 * 5632, 1024, 5632, (bf16*)(ws + (f ? WS_WT13B : WS_WT13A)), orow - n0, scr, kb, nb, F.lane); continue; }
        r -= 2 * I13;
        if (r < 2 * I2) { const int f = r >= I2; r -= f * I2; transpose_item(F.in[f ? I_F2W2 : I_F1W2] + (size_t)l * DFF * 1024, DFF, 1024, (bf16*)(ws + (f ? WS_WT2B : WS_WT2A)), 0, scr, r / 32, r % 32, F.lane); continue; }
        r -= 2 * I2;
        if (r < IIN) { transpose_item(F.in[I_WIN] + (size_t)l * 1024 * 2624, 1024, 2624, (bf16*)(ws + WS_WTIN), 0, scr, r / 82, r % 82, F.lane); continue; }
        r -= IIN;
        if (r < IUQ) { transpose_item(F.in[I_WUQ] + (size_t)l * 384 * 576, 384, 576, (bf16*)(ws + WS_WTUQ), 0, scr, r / 18, r % 18, F.lane); continue; }
        r -= IUQ;
        if (r < 2 * IUK) { const int f = r >= IUK; r -= f * IUK; transpose_item(F.in[f ? I_WUV : I_WUK] + (size_t)l * 256 * 384, 256, 384, (bf16*)(ws + WS_WTUKV), f * 384, scr, r / 12, r % 12, F.lane); continue; }
        r -= 2 * IUK;
        transpose_item(F.in[I_WOUT] + (size_t)l * 1024 * 1024, 1024, 1024, (bf16*)(ws + WS_WTOUT), 0, scr, r / 32, r % 32, F.lane);
    }
    { const int gt = blockIdx.x * NTHR + F.tid, ngt = F.G * NTHR;
      v4u z = {0u, 0u, 0u, 0u};
      v4u* p1 = (v4u*)(ws + WS_WTIN + (size_t)2624 * 1024 * 2); for (int i = gt; i < 192 * 1024 * 2 / 16; i += ngt) p1[i] = z;
      v4u* p2 = (v4u*)(ws + WS_WTUQ + (size_t)576 * 384 * 2); for (int i = gt; i < 192 * 384 * 2 / 16; i += ngt) p2[i] = z; }
    if (l != 0) return;
    if (blockIdx.x == F.G - 1) { const int pos = F.tid >> 3, i = F.tid & 7; const float inv = exp2f(-(float)i * 1.6609640474436813f);
        const float rev = (float)pos * inv * 0.15915494309189535f; float* R = (float*)(ws + WS_ROPE);
        R[F.tid * 2] = __builtin_amdgcn_cosf(rev); R[F.tid * 2 + 1] = __builtin_amdgcn_sinf(rev); }
    LAS float* sc = (LAS float*)(F.lds + 69632);
    LAS float* part = (LAS float*)(F.lds + 106496);
    __syncthreads();
    for (int i = F.tid; i < 9 * 1024; i += NTHR) { const int b = i >> 10, k = i & 1023; const float c = b == 0 ? F.in[I_CCTX][k] : F.in[I_C][(b - 1) * 1024 + k]; sc[i] = c / (1.0f + __expf(-c)); }
    __syncthreads();
    float* MOD = (float*)(ws + WS_MOD);
    for (int j = blockIdx.x; j < 288; j += F.G) {
        const int ll = j / 144, c0 = (j % 144) * 64;
        const float* wp = F.in[I_WMOD] + (size_t)ll * 1024 * 9216 + (size_t)(F.wave * 128) * 9216 + c0 + F.lane;
        float a0 = 0.f, a1 = 0.f, a2 = 0.f, a3 = 0.f, a4 = 0.f, a5 = 0.f, a6 = 0.f, a7 = 0.f, a8 = 0.f;
#pragma unroll 8
        for (int kk = 0; kk < 128; ++kk) { const float w = wp[(size_t)kk * 9216]; const LAS float* s = sc + F.wave * 128 + kk;
            a0 += s[0] * w; a1 += s[1024] * w; a2 += s[2048] * w; a3 += s[3072] * w; a4 += s[4096] * w; a5 += s[5120] * w; a6 += s[6144] * w; a7 += s[7168] * w; a8 += s[8192] * w; }
        LAS float* pp = part + F.wave * 576 + F.lane;
        pp[0] = a0; pp[64] = a1; pp[128] = a2; pp[192] = a3; pp[256] = a4; pp[320] = a5; pp[384] = a6; pp[448] = a7; pp[512] = a8;
        __syncthreads();
        for (int i = F.tid; i < 576; i += NTHR) { float s = 0.f;
#pragma unroll
            for (int w = 0; w < 8; ++w) s += part[w * 576 + i];
            const int b = i >> 6, c = i & 63; MOD[(size_t)(ll * 9 + b) * 9216 + c0 + c] = s + F.in[I_BMOD][ll * 9216 + c0 + c]; }
        __syncthreads();
    }
}

__device__ __forceinline__ void norm_phase(Frame& F, const float* xc, const float* xl, const float* gain, const float* modl, int ni, bf16* U) {
    for (int m = F.gw; m < MTOK; m += F.ngw) {
        const float* xr = m < MCTX ? xc + (size_t)m * D : xl + (size_t)(m - MCTX) * D;
        const int bk = m < MCTX ? 0 : 1 + ((m - MCTX) >> 10);
        const float* sh = modl + bk * 9216 + (3 * ni) * 1024; const float* sc = sh + 1024;
        f32x4 v[4]; float ss = 0.f;
#pragma unroll
        for (int j = 0; j < 4; ++j) { v[j] = *(const f32x4*)(xr + 4 * F.lane + 256 * j); ss += (v[j].x * v[j].x + v[j].y * v[j].y) + (v[j].z * v[j].z + v[j].w * v[j].w); }
        const float rstd = rsqrtf(wave_sum(ss) * (1.0f / D) + EPS);
#pragma unroll
        for (int j = 0; j < 4; ++j) { const int k = 4 * F.lane + 256 * j;
            const f32x4 g = *(const f32x4*)(gain + k), s1 = *(const f32x4*)(sc + k), s0 = *(const f32x4*)(sh + k);
            const f32x4 y = v[j] * rstd * g * (s1 + 1.0f) + s0;
            v2u o; o.x = pk2(y.x, y.y); o.y = pk2(y.z, y.w); *(v2u*)(U + (size_t)m * D + k) = o; }
    }
}
__device__ __forceinline__ void final_norm_phase(Frame& F, float* X, const float* gain) {
    for (int m = F.gw; m < MTOK; m += F.ngw) {
        float* xr = X + (size_t)m * D;
        f32x4 v[4]; float ss = 0.f;
#pragma unroll
        for (int j = 0; j < 4; ++j) { v[j] = *(const f32x4*)(xr + 4 * F.lane + 256 * j); ss += (v[j].x * v[j].x + v[j].y * v[j].y) + (v[j].z * v[j].z + v[j].w * v[j].w); }
        const float rstd = rsqrtf(wave_sum(ss) * (1.0f / D) + EPS);
#pragma unroll
        for (int j = 0; j < 4; ++j) { const int k = 4 * F.lane + 256 * j; const f32x4 g = *(const f32x4*)(gain + k); *(f32x4*)(xr + k) = v[j] * rstd * g; }
    }
}

__device__ __forceinline__ void rope4(float (&x)[4], int lane, int t, const float* R) {
    const int part = (lane & 7) >> 2, second = (lane & 3) >> 1, i0 = (lane & 1) * 4; const int pos = part ? (t & 63) : (t >> 6);
#pragma unroll
    for (int e = 0; e < 4; ++e) { const float xp = __shfl_xor(x[e], 2); const float c = R[(pos * 8 + i0 + e) * 2], s = R[(pos * 8 + i0 + e) * 2 + 1];
        x[e] = second ? (xp * s + x[e] * c) : (x[e] * c - xp * s); }
}
__device__ __forceinline__ void postproj_phase(Frame& F, int l) {
    unsigned char* ws = F.ws; const bf16* P = (const bf16*)(ws + WS_PH); const float* R = (const float*)(ws + WS_ROPE);
    bf16* CQN = (bf16*)(ws + WS_CQN); bf16* CKV = (bf16*)(ws + WS_CKV); bf16* KR = (bf16*)(ws + WS_KR); bf16* KB = (bf16*)(ws + WS_KB); bf16* VB = (bf16*)(ws + WS_VB); bf16* QB = (bf16*)(ws + WS_QB);
    const float* qn = F.in[I_QNORM] + l * 384; const float* kvn = F.in[I_KVNORM] + l * 256;
    const int lane = F.lane;
    for (int m = F.gw; m < MTOK + 2048; m += F.ngw) {
        if (m < MTOK) {
            const bf16* pr = P + (size_t)m * PCOLS;
            const bool isctx = m < MCTX; const int b = isctx ? (m >> 8) : ((m - MCTX) >> 10), t = isctx ? (m & 255) : ((m - MCTX) & 1023);
            const int keyrow = isctx ? m : MCTX + b * 1280 + 256 + t; const size_t orow = (size_t)((b * 2 + l) * 256 + t);
            {
                unsigned w[3]; float ss = 0.f;
#pragma unroll
                for (int j = 0; j < 3; ++j) { w[j] = *(const unsigned*)(pr + PC_CQ + 2 * lane + 128 * j); const float a = bflo(w[j]), c = bfhi(w[j]); ss += a * a + c * c; }
                const float rstd = rsqrtf(wave_sum(ss) * (1.0f / 384.0f) + EPS);
#pragma unroll
                for (int j = 0; j < 3; ++j) { const int idx = 2 * lane + 128 * j; *(unsigned*)(CQN + (size_t)m * 384 + idx) = pk2(bflo(w[j]) * rstd * qn[idx], bfhi(w[j]) * rstd * qn[idx + 1]); }
            }
            {
                const v2u w = *(const v2u*)(pr + PC_CKV + 4 * lane); float x[4] = {bflo(w.x), bfhi(w.x), bflo(w.y), bfhi(w.y)};
                const float ss = (x[0] * x[0] + x[1] * x[1]) + (x[2] * x[2] + x[3] * x[3]);
                const float rstd = rsqrtf(wave_sum(ss) * (1.0f / 256.0f) + EPS);
                const f32x4 g = *(const f32x4*)(kvn + 4 * lane); f32x4 y = {x[0] * rstd * g.x, x[1] * rstd * g.y, x[2] * rstd * g.z, x[3] * rstd * g.w};
                if (isctx) *(f32x4*)(F.out + O_CKV + orow * 256 + 4 * lane) = y;
                v2u o; o.x = pk2(y.x, y.y); o.y = pk2(y.z, y.w); *(v2u*)(CKV + (size_t)keyrow * 256 + 4 * lane) = o;
            }
            {
                const int j = lane & 31; float x = bf2f(pr[PC_KR + j]); const float xp = __shfl_xor(x, 8);
                if (!isctx) { const int part = j >> 4, i = j & 7, second = (j >> 3) & 1; const int pos = part ? (t & 63) : (t >> 6);
                    const float c = R[(pos * 8 + i) * 2], s = R[(pos * 8 + i) * 2 + 1]; x = second ? (xp * s + x * c) : (x * c - xp * s); }
                if (lane < 32) { if (isctx) F.out[O_KR + orow * 32 + lane] = x; KR[(size_t)keyrow * 32 + lane] = f2bf(x); }
            }
            {
                const v2u w = *(const v2u*)(pr + PC_QB + 4 * lane); float x[4] = {bflo(w.x), bfhi(w.x), bflo(w.y), bfhi(w.y)};
                if (!isctx) rope4(x, lane, t, R);
                v2u o; o.x = pk2(x[0], x[1]); o.y = pk2(x[2], x[3]); *(v2u*)(QB + (size_t)m * 256 + 4 * lane) = o;
            }
            {
                const v2u w = *(const v2u*)(pr + PC_KB + 4 * lane); float x[4] = {bflo(w.x), bfhi(w.x), bflo(w.y), bfhi(w.y)};
                if (isctx) *(f32x4*)(F.out + O_DK + orow * 256 + 4 * lane) = (f32x4){x[0], x[1], x[2], x[3]};
                else rope4(x, lane, t, R);
                v2u o; o.x = pk2(x[0], x[1]); o.y = pk2(x[2], x[3]); *(v2u*)(KB + (size_t)keyrow * 256 + 4 * lane) = o;
            }
            {
                const v2u w = *(const v2u*)(pr + PC_VB + 4 * lane);
                if (isctx) *(f32x4*)(F.out + O_DV + orow * 256 + 4 * lane) = (f32x4){bflo(w.x), bfhi(w.x), bflo(w.y), bfhi(w.y)};
                *(v2u*)(VB + (size_t)keyrow * 256 + 4 * lane) = w;
            }
        } else {
            const int r = m - MTOK, b = r >> 8, j = r & 255; const int keyrow = MCTX + b * 1280 + j; const size_t src = (size_t)((b * 2 + l) * 256 + j);
            { const f32x4 x = *(const f32x4*)(F.in[I_CCKV] + src * 256 + 4 * lane); v2u o; o.x = pk2(x.x, x.y); o.y = pk2(x.z, x.w); *(v2u*)(CKV + (size_t)keyrow * 256 + 4 * lane) = o; }
            if (lane < 32) KR[(size_t)keyrow * 32 + lane] = f2bf(F.in[I_CKR][src * 32 + lane]);
            { const f32x4 x = *(const f32x4*)(F.in[I_CDK] + src * 256 + 4 * lane); v2u o; o.x = pk2(x.x, x.y); o.y = pk2(x.z, x.w); *(v2u*)(KB + (size_t)keyrow * 256 + 4 * lane) = o; }
            { const f32x4 x = *(const f32x4*)(F.in[I_CDV] + src * 256 + 4 * lane); v2u o; o.x = pk2(x.x, x.y); o.y = pk2(x.z, x.w); *(v2u*)(VB + (size_t)keyrow * 256 + 4 * lane) = o; }
        }
    }
}

template <int KS>
__device__ __forceinline__ void attn_tile(const bf16x8 (&qf)[KS], LAS const unsigned char* Kt, int kstr, LAS const unsigned char* Vt, int vstr, float sl2, float& m_, float& l_, f32x4 (&O)[4], int lane) {
    const int r = lane & 15, g = lane >> 4;
    f32x4 s[4];
#pragma unroll
    for (int kt = 0; kt < 4; ++kt) {
        s[kt] = (f32x4){0.f, 0.f, 0.f, 0.f};
        LAS const unsigned char* kp = Kt + (kt * 16 + r) * kstr + g * 16;
#pragma unroll
        for (int ks = 0; ks < KS; ++ks) { const bf16x8 a = *(LAS const bf16x8*)(kp + ks * 64); s[kt] = mfma16(a, qf[ks], s[kt]); }
    }
    float mx = s[0][0];
#pragma unroll
    for (int kt = 0; kt < 4; ++kt)
#pragma unroll
        for (int j = 0; j < 4; ++j) mx = fmaxf(mx, s[kt][j]);
    mx = fmaxf(mx, __shfl_xor(mx, 16)); mx = fmaxf(mx, __shfl_xor(mx, 32));
    const float mn = fmaxf(m_, mx * sl2);
    const float alpha = __builtin_amdgcn_exp2f(m_ - mn);
    float ps = 0.f;
#pragma unroll
    for (int kt = 0; kt < 4; ++kt)
#pragma unroll
        for (int j = 0; j < 4; ++j) { const float p = __builtin_amdgcn_exp2f(s[kt][j] * sl2 - mn); s[kt][j] = p; ps += p; }
    ps += __shfl_xor(ps, 16); ps += __shfl_xor(ps, 32);
    l_ = l_ * alpha + ps; m_ = mn;
#pragma unroll
    for (int dt = 0; dt < 4; ++dt) O[dt] = O[dt] * alpha;
#pragma unroll
    for (int kb = 0; kb < 2; ++kb) {
        v4u pw; pw.x = pk2(s[2 * kb][0], s[2 * kb][1]); pw.y = pk2(s[2 * kb][2], s[2 * kb][3]); pw.z = pk2(s[2 * kb + 1][0], s[2 * kb + 1][1]); pw.w = pk2(s[2 * kb + 1][2], s[2 * kb + 1][3]);
        const bf16x8 pf = __builtin_bit_cast(bf16x8, pw);
#pragma unroll
        for (int dt = 0; dt < 4; ++dt) {
            LAS const unsigned char* vp = Vt + (32 * kb + 4 * g + (r >> 2)) * vstr + (16 * dt + 4 * (r & 3)) * 2;
            const s16x4 lo = vtr(vp), hi = vtr(vp + 16 * vstr);
            const bf16x8 vf = {lo[0], lo[1], lo[2], lo[3], hi[0], hi[1], hi[2], hi[3]};
            O[dt] = mfma16(vf, pf, O[dt]);
        }
    }
}

constexpr int KSTR_A = 208, VSTR = 144, KSTR_B = 144;
constexpr int ATT_K_OFF = 0, ATT_V_OFF = 16384;

__device__ __forceinline__ void mla_unit(Frame& F, int l, bool lat, int b, int h, int qt) {
    unsigned char* ws = F.ws; const bf16* QA = (const bf16*)(ws + WS_QA); const bf16* KNV = (const bf16*)(ws + WS_KNV); const bf16* KR = (const bf16*)(ws + WS_KR); bf16* MIX = (bf16*)(ws + WS_U);
    const int tok0 = lat ? MCTX + b * 1024 + qt * 128 : b * 256 + qt * 128, keyrow0 = lat ? MCTX + b * 1280 : b * 256, NK = lat ? 1280 : 256;
    const int lane = F.lane, r = lane & 15, g = lane >> 4; const int trow = tok0 + 16 * F.wave + r;
    bf16x8 qf[3];
#pragma unroll
    for (int ks = 0; ks < 3; ++ks) qf[ks] = *(const bf16x8*)(QA + (size_t)trow * 768 + h * 96 + 32 * ks + 8 * g);
    if (lat) {
        const float* R = (const float*)(ws + WS_ROPE); const int t = qt * 128 + 16 * F.wave + r; const int pos = g < 2 ? (t >> 6) : (t & 63);
        const v4u me = __builtin_bit_cast(v4u, qf[2]); v4u pa; float o[8];
#pragma unroll
        for (int d = 0; d < 4; ++d) pa[d] = (unsigned)__shfl_xor((int)me[d], 16);
#pragma unroll
        for (int i = 0; i < 8; ++i) { const float x = (i & 1) ? bfhi(me[i >> 1]) : bflo(me[i >> 1]), xp = (i & 1) ? bfhi(pa[i >> 1]) : bflo(pa[i >> 1]);
            const float c = R[(pos * 8 + i) * 2], s = R[(pos * 8 + i) * 2 + 1]; o[i] = (g & 1) ? (xp * s + x * c) : (x * c - xp * s); }
        v4u w; w.x = pk2(o[0], o[1]); w.y = pk2(o[2], o[3]); w.z = pk2(o[4], o[5]); w.w = pk2(o[6], o[7]); qf[2] = __builtin_bit_cast(bf16x8, w);
    }
    float m_ = -1e30f, l_ = 0.f; f32x4 O[4];
#pragma unroll
    for (int dt = 0; dt < 4; ++dt) O[dt] = (f32x4){0.f, 0.f, 0.f, 0.f};
    LAS unsigned char* Kt = F.lds + ATT_K_OFF; LAS unsigned char* Vt = F.lds + ATT_V_OFF;
    const float sl2 = 0.10206207261596575f * 1.4426950408889634f;
    for (int k0 = 0; k0 < NK; k0 += 64) {
        __syncthreads();
        for (int c = F.tid; c < 1280; c += NTHR) {
            if (c < 512) { const int row = c >> 3, ch = c & 7; *(LAS v4u*)(Kt + row * KSTR_A + ch * 16) = *(const v4u*)(KNV + (size_t)(keyrow0 + k0 + row) * 768 + h * 64 + ch * 8); }
            else if (c < 768) { const int cc = c - 512, row = cc >> 2, ch = cc & 3; *(LAS v4u*)(Kt + row * KSTR_A + 128 + ch * 16) = *(const v4u*)(KR + (size_t)(keyrow0 + k0 + row) * 32 + ch * 8); }
            else { const int cc = c - 768, row = cc >> 3, ch = cc & 7; *(LAS v4u*)(Vt + row * VSTR + ch * 16) = *(const v4u*)(KNV + (size_t)(keyrow0 + k0 + row) * 768 + 384 + h * 64 + ch * 8); }
        }
        __syncthreads();
        attn_tile<3>(qf, Kt, KSTR_A, Vt, VSTR, sl2, m_, l_, O, lane);
    }
    const float il = 1.0f / l_;
#pragma unroll
    for (int dt = 0; dt < 4; ++dt) { v2u o; o.x = pk2(O[dt][0] * il, O[dt][1] * il); o.y = pk2(O[dt][2] * il, O[dt][3] * il);
        *(v2u*)(MIX + (size_t)trow * 1024 + h * 64 + 16 * dt + 4 * g) = o; }
}

__device__ __forceinline__ void diff_unit(Frame& F, int l, bool lat, int b, int h, int qt) {
    unsigned char* ws = F.ws; const bf16* QB = (const bf16*)(ws + WS_QB); const bf16* KB = (const bf16*)(ws + WS_KB); const bf16* VB = (const bf16*)(ws + WS_VB); bf16* MIX = (bf16*)(ws + WS_U);
    const int tok0 = lat ? MCTX + b * 1024 + qt * 128 : b * 256 + qt * 128, keyrow0 = lat ? MCTX + b * 1280 : b * 256, NK = lat ? 1280 : 256;
    const int lane = F.lane, r = lane & 15, g = lane >> 4; const int trow = tok0 + 16 * F.wave + r;
    bf16x8 q0[1], q1[1];
    q0[0] = *(const bf16x8*)(QB + (size_t)trow * 256 + h * 64 + 8 * g); q1[0] = *(const bf16x8*)(QB + (size_t)trow * 256 + h * 64 + 32 + 8 * g);
    float m0 = -1e30f, l0 = 0.f, m1 = -1e30f, l1 = 0.f; f32x4 O0[4], O1[4];
#pragma unroll
    for (int dt = 0; dt < 4; ++dt) { O0[dt] = (f32x4){0.f, 0.f, 0.f, 0.f}; O1[dt] = (f32x4){0.f, 0.f, 0.f, 0.f}; }
    LAS unsigned char* Kt = F.lds + ATT_K_OFF; LAS unsigned char* Vt = F.lds + ATT_V_OFF;
    const float sl2 = 0.17677669529663687f * 1.4426950408889634f;
    for (int k0 = 0; k0 < NK; k0 += 64) {
        __syncthreads();
        for (int c = F.tid; c < 1024; c += NTHR) {
            if (c < 512) { const int row = c >> 3, ch = c & 7; *(LAS v4u*)(Kt + row * KSTR_B + ch * 16) = *(const v4u*)(KB + (size_t)(keyrow0 + k0 + row) * 256 + h * 64 + ch * 8); }
            else { const int cc = c - 512, row = cc >> 3, ch = cc & 7; *(LAS v4u*)(Vt + row * VSTR + ch * 16) = *(const v4u*)(VB + (size_t)(keyrow0 + k0 + row) * 256 + h * 64 + ch * 8); }
        }
        __syncthreads();
        attn_tile<1>(q0, Kt, KSTR_B, Vt, VSTR, sl2, m0, l0, O0, lane);
        attn_tile<1>(q1, Kt + 64, KSTR_B, Vt, VSTR, sl2, m1, l1, O1, lane);
    }
    float d1 = 0.f, d2 = 0.f;
    #pragma unroll 4
    for (int i = 0; i < 32; ++i) { d1 += F.in[I_LQ1][l * 32 + i] * F.in[I_LK1][l * 32 + i]; d2 += F.in[I_LQ2][l * 32 + i] * F.in[I_LK2][l * 32 + i]; }
    const float lam = expf(d1) - expf(d2) + (l == 0 ? 0.2f : (0.8f - 0.6f * 0.7408182206817179f));
    const float i0 = 1.0f / l0, i1 = lam / l1;
#pragma unroll
    for (int dt = 0; dt < 4; ++dt) { v2u o; o.x = pk2(O0[dt][0] * i0 - O1[dt][0] * i1, O0[dt][1] * i0 - O1[dt][1] * i1); o.y = pk2(O0[dt][2] * i0 - O1[dt][2] * i1, O0[dt][3] * i0 - O1[dt][3] * i1);
        *(v2u*)(MIX + (size_t)trow * 1024 + 384 + h * 64 + 16 * dt + 4 * g) = o; }
}

constexpr int GL_GS = 0, GL_QE = 12288, GL_KE = 21504, GL_KDT = 30720, GL_VT = 37632, GL_ST = 51456, GL_AT = 65280, GL_STR = 144;
__device__ __forceinline__ void gla_unit(Frame& F, int l, bool lat, int b, int h, int dir) {
    unsigned char* ws = F.ws; const bf16* P = (const bf16*)(ws + WS_PH); bf16* MIX = (bf16*)(ws + WS_U); bf16* OCB = (bf16*)(ws + WS_OCB);
    const int N = lat ? 1024 : 256, nc = N / 64, tokbase = lat ? MCTX + b * 1024 : b * 256;
    const int lane = F.lane, r = lane & 15, g = lane >> 4, w = F.wave, tid = F.tid;
    LAS float* GS = (LAS float*)(F.lds + GL_GS);
    LAS unsigned char* QE = F.lds + GL_QE; LAS unsigned char* KE = F.lds + GL_KE; LAS unsigned char* KDT = F.lds + GL_KDT; LAS unsigned char* VT = F.lds + GL_VT; LAS unsigned char* ST = F.lds + GL_ST; LAS unsigned char* AT = F.lds + GL_AT;
    const float* wg = F.in[dir ? I_WGB : I_WGF] + l * 16 * 192; const float* bg = F.in[dir ? I_BGB : I_BGF] + l * 192;
    __syncthreads();
    for (int i = tid; i < (64 + 64 + 96) * 12; i += NTHR) { const int row = i / 12, c = i % 12; LAS unsigned char* base = row < 64 ? QE + row * GL_STR : (row < 128 ? KE + (row - 64) * GL_STR : ST + (row - 128) * GL_STR);
        *(LAS unsigned*)(base + 96 + c * 4) = 0u; }
    f32x4 S[3];
#pragma unroll
    for (int dt = 0; dt < 3; ++dt) S[dt] = (f32x4){0.f, 0.f, 0.f, 0.f};
    if (lat && w < 6) { const float* s0 = F.in[dir ? I_SB : I_SF] + (size_t)((b * 2 + l) * 4 + h) * 4608;
#pragma unroll
        for (int dt = 0; dt < 3; ++dt)
#pragma unroll
            for (int j = 0; j < 4; ++j) S[dt][j] = s0[(16 * dt + 4 * g + j) * 96 + 16 * w + r]; }
    if (w < 6) {
#pragma unroll
        for (int dt = 0; dt < 3; ++dt) { v2u o; o.x = pk2(S[dt][0], S[dt][1]); o.y = pk2(S[dt][2], S[dt][3]); *(LAS v2u*)(ST + (16 * w + r) * GL_STR + (16 * dt + 4 * g) * 2) = o; }
    }
    for (int c = 0; c < nc; ++c) {
        __syncthreads();
        for (int i = tid; i < 3072; i += NTHR) { const int s = i / 48, d = i % 48; const int pi = 64 * c + s; const int tok = tokbase + (dir ? N - 1 - pi : pi);
            const bf16* gl = P + (size_t)tok * PCOLS + PC_GLF + dir * 16; float x = bg[h * 48 + d];
#pragma unroll
            for (int q = 0; q < 16; ++q) x += bf2f(gl[q]) * wg[q * 192 + h * 48 + d];
            const float ls = fminf(x, 0.f) - log1pf(__expf(-fabsf(x)));
            GS[s * 48 + d] = ls * (1.0f / 16.0f); }
        __syncthreads();
        if (tid < 48) { float a = 0.f; for (int s = 0; s < 64; ++s) { a += GS[s * 48 + tid]; GS[s * 48 + tid] = a; } }
        __syncthreads();
        for (int i = tid; i < 3072; i += NTHR) { const int s = i / 48, d = i % 48; const int pi = 64 * c + s; const int tok = tokbase + (dir ? N - 1 - pi : pi);
            const float bc = GS[s * 48 + d], bl = GS[63 * 48 + d];
            const float qv = bf2f(P[(size_t)tok * PCOLS + PC_GQ + h * 48 + d]) * 0.14433756729740643f, kv = bf2f(P[(size_t)tok * PCOLS + PC_GK + h * 48 + d]);
            *(LAS bf16*)(QE + s * GL_STR + d * 2) = f2bf(qv * __expf(bc)); *(LAS bf16*)(KE + s * GL_STR + d * 2) = f2bf(kv * __expf(-bc)); *(LAS bf16*)(KDT + d * GL_STR + s * 2) = f2bf(kv * __expf(bl - bc)); }
        for (int i = tid; i < 6144; i += NTHR) { const int s = i / 96, v = i % 96; const int pi = 64 * c + s; const int tok = tokbase + (dir ? N - 1 - pi : pi);
            *(LAS bf16*)(VT + v * GL_STR + s * 2) = P[(size_t)tok * PCOLS + PC_GV + h * 96 + v]; }
        __syncthreads();
#pragma unroll
        for (int tl = 0; tl < 2; ++tl) { const int tile = 2 * w + tl, ti = tile >> 2, si = tile & 3; f32x4 cc = (f32x4){0.f, 0.f, 0.f, 0.f};
#pragma unroll
            for (int ks = 0; ks < 2; ++ks) { const bf16x8 a = *(LAS const bf16x8*)(KE + (16 * si + r) * GL_STR + (32 * ks + 8 * g) * 2); const bf16x8 bq = *(LAS const bf16x8*)(QE + (16 * ti + r) * GL_STR + (32 * ks + 8 * g) * 2); cc = mfma16(a, bq, cc); }
            const int tq = 16 * ti + r; float o[4];
#pragma unroll
            for (int j = 0; j < 4; ++j) o[j] = (16 * si + 4 * g + j <= tq) ? cc[j] : 0.f;
            v2u ow; ow.x = pk2(o[0], o[1]); ow.y = pk2(o[2], o[3]); *(LAS v2u*)(AT + tq * GL_STR + (16 * si + 4 * g) * 2) = ow; }
        if (w < 6) {
#pragma unroll
            for (int dt = 0; dt < 3; ++dt) { f32x4 u = (f32x4){0.f, 0.f, 0.f, 0.f};
#pragma unroll
                for (int ks = 0; ks < 2; ++ks) { const bf16x8 a = *(LAS const bf16x8*)(KDT + (16 * dt + r) * GL_STR + (32 * ks + 8 * g) * 2); const bf16x8 bv = *(LAS const bf16x8*)(VT + (16 * w + r) * GL_STR + (32 * ks + 8 * g) * 2); u = mfma16(a, bv, u); }
#pragma unroll
                for (int j = 0; j < 4; ++j) S[dt][j] = __expf(GS[63 * 48 + 16 * dt + 4 * g + j]) * S[dt][j] + u[j]; }
        }
        __syncthreads();
#pragma unroll
        for (int tl = 0; tl < 3; ++tl) { const int tile = w + 8 * tl, ti = tile / 6, vi = tile % 6; f32x4 cc = (f32x4){0.f, 0.f, 0.f, 0.f};
#pragma unroll
            for (int ks = 0; ks < 2; ++ks) { const bf16x8 a = *(LAS const bf16x8*)(VT + (16 * vi + r) * GL_STR + (32 * ks + 8 * g) * 2); const bf16x8 bq = *(LAS const bf16x8*)(AT + (16 * ti + r) * GL_STR + (32 * ks + 8 * g) * 2); cc = mfma16(a, bq, cc); }
#pragma unroll
            for (int ks = 0; ks < 2; ++ks) { const bf16x8 a = *(LAS const bf16x8*)(ST + (16 * vi + r) * GL_STR + (32 * ks + 8 * g) * 2); const bf16x8 bq = *(LAS const bf16x8*)(QE + (16 * ti + r) * GL_STR + (32 * ks + 8 * g) * 2); cc = mfma16(a, bq, cc); }
            const int pi = 64 * c + 16 * ti + r; const int tok = tokbase + (dir ? N - 1 - pi : pi);
            v2u ow; ow.x = pk2(cc[0], cc[1]); ow.y = pk2(cc[2], cc[3]);
            bf16* dst = dir ? OCB + (size_t)tok * 384 + h * 96 + 16 * vi + 4 * g : MIX + (size_t)tok * 1024 + 640 + h * 96 + 16 * vi + 4 * g;
            *(v2u*)dst = ow; }
        __syncthreads();
        if (w < 6) {
#pragma unroll
            for (int dt = 0; dt < 3; ++dt) { v2u o; o.x = pk2(S[dt][0], S[dt][1]); o.y = pk2(S[dt][2], S[dt][3]); *(LAS v2u*)(ST + (16 * w + r) * GL_STR + (16 * dt + 4 * g) * 2) = o; }
        }
    }
    if (!lat && w < 6) { float* so = F.out + (dir ? O_SB : O_SF) + (size_t)((b * 2 + l) * 4 + h) * 4608;
#pragma unroll
        for (int dt = 0; dt < 3; ++dt)
#pragma unroll
            for (int j = 0; j < 4; ++j) so[(16 * dt + 4 * g + j) * 96 + 16 * w + r] = S[dt][j]; }
}

constexpr int NU_GL = 64, NU_ML = 384, NU_DL = 256, NU_GC = 256, NU_MC = 384, NU_DC = 256, NU_ALL = NU_GL + NU_ML + NU_DL + NU_GC + NU_MC + NU_DC;
__device__ __forceinline__ void mixer_phase(Frame& F, int l, int rep) {
    LAS int* us = (LAS int*)(F.lds + 140000);
    unsigned* ctr = (unsigned*)(F.ws + WS_CTL) + 64 * l + 256 * rep;
    for (;;) {
        __syncthreads();
        if (F.tid == 0) *us = (int)atomicAdd(ctr, 1u);
        __syncthreads();
        int u = *us; if (u >= NU_ALL) break;
        int type, lat, b, h, x;
        if (u < NU_GL) { type = 0; lat = 1; b = u >> 3; h = (u >> 1) & 3; x = u & 1; }
        else if ((u -= NU_GL) < NU_ML) { type = 1; lat = 1; b = u / 48; const int rr = u % 48; h = rr >> 3; x = rr & 7; }
        else if ((u -= NU_ML) < NU_DL) { type = 2; lat = 1; b = u >> 5; const int rr = u & 31; h = rr >> 3; x = rr & 7; }
        else if ((u -= NU_DL) < NU_GC) { type = 0; lat = 0; b = u >> 3; h = (u >> 1) & 3; x = u & 1; }
        else if ((u -= NU_GC) < NU_MC) { type = 1; lat = 0; b = u / 12; const int rr = u % 12; h = rr >> 1; x = rr & 1; }
        else { u -= NU_MC; type = 2; lat = 0; b = u >> 3; const int rr = u & 7; h = rr >> 1; x = rr & 1; }
        Frame F2 = F; { int t = F.tid; asm volatile("" : "+v"(t)); F2.tid = t; F2.lane = t & 63; F2.wave = __builtin_amdgcn_readfirstlane(t >> 6);
            unsigned char* w2 = F.ws; asm volatile("" : "+s"(w2)); F2.ws = w2; }
        if (type == 0) gla_unit(F2, l, lat != 0, b, h, x);
        else if (type == 1) mla_unit(F2, l, lat != 0, b, h, x);
        else diff_unit(F2, l, lat != 0, b, h, x);
    }
}

__device__ __forceinline__ void merge_phase(Frame& F, int l) {
    unsigned char* ws = F.ws; bf16* MIX = (bf16*)(ws + WS_U); const bf16* OCB = (const bf16*)(ws + WS_OCB); const bf16* P = (const bf16*)(ws + WS_PH);
    const float* on = F.in[I_ONORM] + l * 384; const float* dn = F.in[I_DNORM] + l * 64; const float* gn = F.in[I_GNORM] + l * 96;
    const float oml = 1.0f - (l == 0 ? 0.2f : (0.8f - 0.6f * 0.7408182206817179f));
    const int lane = F.lane;
    for (int m = F.gw; m < MTOK; m += F.ngw) {
        bf16* row = MIX + (size_t)m * 1024;
        unsigned wa[3], wb[2], wc[3], wd[3], wr_[3];
#pragma unroll
        for (int j = 0; j < 3; ++j) { wa[j] = *(const unsigned*)(row + lane * 6 + 2 * j); wc[j] = *(const unsigned*)(row + 640 + lane * 6 + 2 * j); wd[j] = *(const unsigned*)(OCB + (size_t)m * 384 + lane * 6 + 2 * j);
            wr_[j] = *(const unsigned*)(P + (size_t)m * PCOLS + PC_RC + lane * 6 + 2 * j); }
        { const v2u t = *(const v2u*)(row + 384 + lane * 4); wb[0] = t.x; wb[1] = t.y; }
        float xa[6], xb[4], xc[6]; float sa = 0.f, sb = 0.f, sc = 0.f;
#pragma unroll
        for (int j = 0; j < 3; ++j) { xa[2 * j] = bflo(wa[j]); xa[2 * j + 1] = bfhi(wa[j]); xc[2 * j] = bflo(wc[j]) + bflo(wd[j]); xc[2 * j + 1] = bfhi(wc[j]) + bfhi(wd[j]); }
#pragma unroll
        for (int j = 0; j < 2; ++j) { xb[2 * j] = bflo(wb[j]); xb[2 * j + 1] = bfhi(wb[j]); }
#pragma unroll
        for (int e = 0; e < 6; ++e) { sa += xa[e] * xa[e]; sc += xc[e] * xc[e]; }
#pragma unroll
        for (int e = 0; e < 4; ++e) sb += xb[e] * xb[e];
        const float ra = rsqrtf(wave_sum(sa) * (1.0f / 384.0f) + EPS), rb = rsqrtf(grp16_sum(sb) * (1.0f / 64.0f) + EPS) * oml, rc = rsqrtf(grp16_sum(sc) * (1.0f / 96.0f) + EPS);
        float ya[6], yb[4], yc[6];
#pragma unroll
        for (int e = 0; e < 6; ++e) { ya[e] = xa[e] * ra * on[lane * 6 + e];
            const float rv = (e & 1) ? bfhi(wr_[e >> 1]) : bflo(wr_[e >> 1]); const float sg = rv / (1.0f + __expf(-rv));
            yc[e] = xc[e] * rc * gn[(lane & 15) * 6 + e] * sg; }
#pragma unroll
        for (int e = 0; e < 4; ++e) yb[e] = xb[e] * rb * dn[(lane & 15) * 4 + e];
#pragma unroll
        for (int j = 0; j < 3; ++j) { *(unsigned*)(row + lane * 6 + 2 * j) = pk2(ya[2 * j], ya[2 * j + 1]); *(unsigned*)(row + 640 + lane * 6 + 2 * j) = pk2(yc[2 * j], yc[2 * j + 1]); }
        { v2u o; o.x = pk2(yb[0], yb[1]); o.y = pk2(yb[2], yb[3]); *(v2u*)(row + 384 + lane * 4) = o; }
    }
}

#define RLX_AGENT __ATOMIC_RELAXED, __HIP_MEMORY_SCOPE_AGENT
#define XB_TMO      128
#define XB_XCNT(j)  (256  + 64 * (j))
#define XB_XSUB(j)  (1280 + 64 * (j))
#define XB_XGEN(j)  (2304 + 64 * (j))
#define XB_TOP      3328
#define XB_TOPGEN   3392
#define XCD_BAR_WORDS 3456
#define XB_SPIN_CAP (1u << 18)

__device__ __forceinline__ unsigned xb_ld(unsigned* p)              { return __hip_atomic_load(p, __ATOMIC_RELAXED, __HIP_MEMORY_SCOPE_AGENT); }
__device__ __forceinline__ unsigned xb_add(unsigned* p, unsigned v) { return __hip_atomic_fetch_add(p, v, __ATOMIC_RELAXED, __HIP_MEMORY_SCOPE_AGENT); }
__device__ __forceinline__ unsigned xb_xcc_id() { return (unsigned)__builtin_amdgcn_s_getreg((3 << 11) | 20) & 0xFu; }
#define XB_SPIN(cond, bar) do { unsigned _sp = 0; while (cond) { __builtin_amdgcn_s_sleep(1); \
    if ((++_sp & 255u) == 0u) { if (xb_ld(&(bar)[XB_TMO])) break; if (_sp > XB_SPIN_CAP) { atomicAdd(&(bar)[XB_TMO], 1u); break; } } } } while (0)

struct XcdBarrier {
    unsigned* bar; unsigned x;
    volatile LAS unsigned* st;
};

__device__ __forceinline__ XcdBarrier xcd_barrier_post(unsigned* bar, volatile LAS unsigned* st) {
    XcdBarrier b; b.bar = bar; b.x = xb_xcc_id(); b.st = st;
    if (threadIdx.x == 0) (void)xb_add(&bar[XB_XCNT(b.x)], 1u);
    return b;
}
__device__ __forceinline__ void xcd_barrier_complete(unsigned* bar, unsigned x, unsigned& nloc, unsigned& nx) {
    const unsigned G = gridDim.x * gridDim.y * gridDim.z;
    unsigned sum, cnt, mine, sp = 0u;
    for (;;) {
        sum = 0u; cnt = 0u; mine = 0u;
#pragma unroll
        for (unsigned j = 0; j < 16; ++j) { const unsigned c = xb_ld(&bar[XB_XCNT(j)]); sum += c; cnt += (c > 0u) ? 1u : 0u; mine = (j == x) ? c : mine; }
        if (sum == G) break;
        __builtin_amdgcn_s_sleep(1);
        if ((++sp & 255u) == 0u) { if (xb_ld(&bar[XB_TMO])) break; if (sp > XB_SPIN_CAP) { atomicAdd(&bar[XB_TMO], 1u); break; } }
    }
    nloc = mine > 0u ? mine : 1u; nx = cnt > 0u ? cnt : 1u;
}

__device__ __forceinline__ void xcd_barrier(const XcdBarrier& b) {
    asm volatile("s_waitcnt vmcnt(0)" ::: "memory");
    __syncthreads();
    if (threadIdx.x == 0) {
        unsigned* bar = b.bar;
        __builtin_amdgcn_s_waitcnt(0);
        unsigned nloc = b.st[0], nx = b.st[1];
        if (nloc == 0u) { xcd_barrier_complete(bar, b.x, nloc, nx); b.st[0] = nloc; b.st[1] = nx; }
        const unsigned old = xb_add(&bar[XB_XSUB(b.x)], 1u);
        const unsigned gen = old / nloc;
        if (old + 1u == (gen + 1u) * nloc) {
            __builtin_amdgcn_fence(__ATOMIC_RELEASE, "agent");
            asm volatile("s_waitcnt vmcnt(0)" ::: "memory");
            const unsigned og = xb_add(&bar[XB_TOP], 1u);
            const unsigned tg = og / nx;
            if (og + 1u == (tg + 1u) * nx) xb_add(&bar[XB_TOPGEN], 1u);
            else XB_SPIN(xb_ld(&bar[XB_TOPGEN]) == tg, bar);
            __builtin_amdgcn_fence(__ATOMIC_ACQUIRE, "agent");
            xb_add(&bar[XB_XGEN(b.x)], 1u);
            asm volatile("s_waitcnt vmcnt(0)" ::: "memory");
        } else {
            XB_SPIN(xb_ld(&bar[XB_XGEN(b.x)]) == gen, bar);
            __builtin_amdgcn_fence(__ATOMIC_ACQUIRE, "agent");
            asm volatile("s_waitcnt vmcnt(0)" ::: "memory");
        }
    }
    __syncthreads();
}

__global__ void __launch_bounds__(NTHR, 2) mega_fwd(Args args) {
    extern __shared__ __attribute__((aligned(16))) unsigned char lds_raw[];
    cg::grid_group grid = cg::this_grid();
    Frame F;
    F.lds = (LAS unsigned char*)lds_raw;
    F.tid = threadIdx.x; F.lane = F.tid & 63; F.wave = __builtin_amdgcn_readfirstlane(F.tid >> 6);
    F.G = gridDim.x; F.gw = blockIdx.x * NWAVES + F.wave; F.ngw = F.G * NWAVES;
    inptr_t kin = (inptr_t)__builtin_amdgcn_kernarg_segment_ptr();
    asm volatile("" : "+s"(kin));
    F.in = kin; F.out = (float*)kin[N_IN]; F.ws = (unsigned char*)kin[N_IN + 1];
    unsigned char* ws = F.ws;
    float* X = F.out + O_X;
    volatile LAS unsigned* bst = (volatile LAS unsigned*)(F.lds + 140032);
    if (F.tid < 2) bst[F.tid] = 0u;
    __syncthreads();
    XcdBarrier xbar = xcd_barrier_post((unsigned*)(ws + WS_CTL + 65536), bst);
    bf16* U = (bf16*)(ws + WS_U); bf16* PH = (bf16*)(ws + WS_PH);
    const float* MOD = (const float*)(ws + WS_MOD);
    const int bx = (int)blockIdx.x;

#pragma unroll 1
    for (int st = 0; st < 28; ++st) {
        const int l = st / 14, k = st % 14;
        { int t = threadIdx.x; asm volatile("" : "+v"(t)); F.tid = t; F.lane = t & 63; F.wave = __builtin_amdgcn_readfirstlane(t >> 6); F.gw = blockIdx.x * NWAVES + F.wave;
          asm volatile("" : "+s"(kin)); F.in = kin; F.out = (float*)kin[N_IN]; X = F.out + O_X;
          unsigned char* w2 = (unsigned char*)kin[N_IN + 1]; asm volatile("" : "+s"(w2)); F.ws = w2; ws = w2; U = (bf16*)(ws + WS_U); PH = (bf16*)(ws + WS_PH); MOD = (const float*)(ws + WS_MOD); }
        const float* modl = MOD + (size_t)l * 9 * 9216;
        const bool first = (l == 0 && k <= 3);
        const float* xc = first ? F.in[I_XP] : X; const float* xl = first ? F.in[I_XS] : X + (size_t)MCTX * D;
        if (k == 0) { prep_phase(F, l); }
        else if (k == 1 || k == 4 || k == 11) { const int ni = k == 1 ? 0 : (k == 4 ? 1 : 2);
            norm_phase(F, xc, xl, F.in[k == 1 ? I_NF1 : (k == 4 ? I_NMIX : I_NF2)] + l * D, modl, ni, U); }
        else if (k == 2 || k == 12) { pg8::Gemm g{U, (const bf16*)(ws + (k == 2 ? WS_WT13A : WS_WT13B)), MTOK, 2 * DFF, D}; pg8::StaticOrder S; S.init(MTOK, 2 * DFF, F.G, bx); pg8::EpiSwiglu E{PH, DFF};
            pg8::gemm_phase<pg8::EpiSwiglu, pg8::StaticOrder, true, true>(F.lds, g, S, E); }
        else if (k == 3 || k == 10 || k == 13) {
            const bf16* A = k == 10 ? U : PH; const bf16* Bt = (const bf16*)(ws + (k == 3 ? WS_WT2A : (k == 10 ? WS_WTOUT : WS_WT2B))); const int K = k == 10 ? D : DFF;
            const int gi = k == 3 ? 2 : (k == 10 ? 5 : 8); const float gs = k == 10 ? 1.0f : 0.5f;
            pg8::Gemm g{A, Bt, MTOK, D, K}; pg8::StaticOrder S; S.init(MTOK, D, F.G, bx); pg8::EpiResid E{xc, xl, X, modl + gi * 1024, gs};
            pg8::gemm_phase<pg8::EpiResid, pg8::StaticOrder, true, true>(F.lds, g, S, E); }
        else if (k == 5 || k == 7) {
            const int nj = k == 7 ? 2 : 1;
#pragma unroll 1
            for (int j = 0; j < nj; ++j) {
                const bf16* A = k == 5 ? U : (const bf16*)(ws + (j == 0 ? WS_CQN : WS_CKV)); const bf16* Bt = (const bf16*)(ws + (k == 5 ? WS_WTIN : (j == 0 ? WS_WTUQ : WS_WTUKV)));
                bf16* O = k == 5 ? PH : (bf16*)(ws + (j == 0 ? WS_QA : WS_KNV));
                const int M = (k == 7 && j == 1) ? NKEYROWS : MTOK, N = k == 5 ? PCOLS : 768, K = k == 5 ? D : (j == 0 ? 384 : 256);
                pg8::Gemm g{A, Bt, M, N, K}; pg8::StaticOrder S; S.init(M, N, F.G, (bx + 64 * j) % F.G); pg8::EpiBf16P E{O, N};
                pg8::gemm_phase<pg8::EpiBf16P, pg8::StaticOrder, true, true>(F.lds, g, S, E); } }
        else if (k == 6) postproj_phase(F, l);
        else if (k == 8) { mixer_phase(F, l, 0);
#if PROBE_MIXER2
            xcd_barrier(xbar); mixer_phase(F, l, 1);
#endif
        }
        else merge_phase(F, l);
        if (st == 0) grid.sync(); else xcd_barrier(xbar);
    }
    final_norm_phase(F, X, F.in[I_FNORM]);
}

extern "C" void kernel_launch(void* const* d_in, const int* in_sizes, int n_in, void* d_out, int out_size, void* d_ws, size_t ws_size, hipStream_t stream) {
    static int grid = 0;
    if (grid == 0) {
        if (n_in != N_IN || ws_size < WS_END) { fprintf(stderr, "kernel_launch: unexpected n_in %d or ws_size %zu\n", n_in, ws_size); grid = -1; return; }
        int dev = 0, cus = 0, per_cu = 0;
        (void)hipGetDevice(&dev); (void)hipDeviceGetAttribute(&cus, hipDeviceAttributeMultiprocessorCount, dev);
        if (hipFuncSetAttribute((const void*)mega_fwd, hipFuncAttributeMaxDynamicSharedMemorySize, LDS_BYTES) != hipSuccess) fprintf(stderr, "kernel_launch: hipFuncSetAttribute failed\n");
        if (hipOccupancyMaxActiveBlocksPerMultiprocessor(&per_cu, (const void*)mega_fwd, NTHR, LDS_BYTES) != hipSuccess || per_cu < 1) { fprintf(stderr, "kernel_launch: occupancy query gave %d\n", per_cu); per_cu = 1; }
        (void)hipGetLastError();
        grid = cus * per_cu;
    }
    if (grid < 0) return;
    (void)hipMemsetAsync((char*)d_ws + WS_CTL, 0, 131072, stream);
    Args a{};
    for (int i = 0; i < N_IN; ++i) a.in[i] = (const float*)d_in[i];
    a.out = (float*)d_out; a.ws = (unsigned char*)d_ws;
    void* kargs[] = {&a};
    hipError_t e = hipLaunchCooperativeKernel((const void*)mega_fwd, dim3(grid), dim3(NTHR), kargs, LDS_BYTES, stream);
    if (e != hipSuccess) fprintf(stderr, "kernel_launch: cooperative launch failed: %s (grid %d)\n", hipGetErrorString(e), grid);
}
```

```cpp
#include <hip/hip_runtime.h>
#include <hip/hip_cooperative_groups.h>
#include <cstdio>
#include <cstdint>
namespace cg = cooperative_groups;
#ifndef PROBE_MIXER2
#define PROBE_MIXER2 0
#endif
#ifndef PROBE_SYNC2
#define PROBE_SYNC2 0
#endif
#ifndef PROBE_G13
#define PROBE_G13 0
#endif
#ifndef PROBE_BAR2
#define PROBE_BAR2 0
#endif
namespace pg8 {
#define PG8_LAS __attribute__((address_space(3)))
typedef unsigned short bf16_t;
typedef short bf16x8 __attribute__((ext_vector_type(8)));
typedef float f32x4 __attribute__((ext_vector_type(4)));
typedef unsigned u32x4 __attribute__((ext_vector_type(4)));
constexpr int BM = 256, BK = 64, HALF = 128, HTB = HALF * BK * 2  , STAGE_BYTES = 8 * HTB, NXCD = 8, WGM = 8;

__host__ __device__ __forceinline__ int lds_byte(int r, int c) { const int st = (r >> 4) * 2 + (c >> 5), rr = r & 15, cc = c & 31, ob = rr * 64 + cc * 2; return st * 1024 + (ob ^ (((ob >> 9) & 1) << 5)); }
__host__ __device__ __forceinline__ void stage_rc(int b, int& R, int& C) { const int st = b / 1024, sb = b % 1024, swz = sb ^ (((sb >> 9) & 1) << 5); R = (st >> 1) * 16 + swz / 64; C = (st & 1) * 32 + (swz % 64) / 2; }
__host__ __device__ __forceinline__ int perm32(int rho) { const int n = rho >> 4, i = rho & 15; return 8 * (i >> 2) + 4 * n + (i & 3); }

struct Unit { int pm, pn; };
struct Gemm { const bf16_t* A; const bf16_t* Bt; int M, N, K; };

struct StaticOrder {
    int nM, nN, nwg, G, c;
    __host__ __device__ void init(int M, int N, int G_, int c_) { nM = M / BM; nN = N / BM; nwg = nM * nN; G = G_; c = c_; }
    __host__ __device__ bool next(int i, Unit& u) const {
        const long L = (long)i * G + c; if (L >= nwg) return false;
        int wgid = (int)L; { const int q = nwg / NXCD, r = nwg % NXCD, xcd = wgid % NXCD, off = wgid / NXCD; wgid = (xcd < r ? xcd * (q + 1) : r * (q + 1) + (xcd - r) * q) + off; }
        const int nig = WGM * nN, gid = wgid / nig, fm = gid * WGM, gsz = (nM - fm) < WGM ? (nM - fm) : WGM;
        u.pm = fm + ((wgid % nig) % gsz); u.pn = (wgid % nig) / gsz; return true;
    }
    __device__ __forceinline__ void a_ready(const Unit&) const {}
    __device__ __forceinline__ void done(const Unit&) const {}
};

typedef float f32x2_cv __attribute__((ext_vector_type(2))); typedef __bf16 bf16x2_cv __attribute__((ext_vector_type(2)));
__device__ __forceinline__ unsigned cvt_pk_bf16(float lo, float hi) { f32x2_cv v = {lo, hi}; bf16x2_cv b = __builtin_convertvector(v, bf16x2_cv); return __builtin_bit_cast(unsigned, b); }
struct EpiSwiglu {
    static constexpr bool PERM = true, AFTER_DRAIN = false;
    bf16_t* O; int ldc;
    __device__ __forceinline__ void operator()(const f32x4 (&acc)[2][2][4][2], const Unit& u, int wr, int wc, int fr, int fq) const {
        const int row0 = u.pm * BM + wr * 64 + fr; const int col0 = u.pn * HALF + wc * 32 + 8 * fq;
#pragma unroll
        for (int ai = 0; ai < 2; ++ai)
#pragma unroll
            for (int m = 0; m < 4; ++m) {
                bf16_t* rowp = O + (size_t)(row0 + ai * HALF + m * 16) * ldc + col0;
                float r[8];
#pragma unroll
                for (int n = 0; n < 2; ++n)
#pragma unroll
                    for (int e = 0; e < 4; ++e) { const float a = acc[ai][0][m][n][e], b = acc[ai][1][m][n][e];
                        const float s = a * __builtin_amdgcn_rcpf(1.0f + __builtin_amdgcn_exp2f(-1.4426950408889634f * a)); r[n * 4 + e] = s * b; }
                u32x4 w; w.x = cvt_pk_bf16(r[0], r[1]); w.y = cvt_pk_bf16(r[2], r[3]); w.z = cvt_pk_bf16(r[4], r[5]); w.w = cvt_pk_bf16(r[6], r[7]);
                *(u32x4*)rowp = w;
            }
    }
};
struct EpiResid {
    static constexpr bool PERM = false, AFTER_DRAIN = false;
    const float* xin_ctx; const float* xin_lat; float* out; const float* gate_base; float gs;
    __device__ __forceinline__ void operator()(const f32x4 (&acc)[2][2][4][2], const Unit& u, int wr, int wc, int fr, int fq) const {
        const int bk = u.pm < 32 ? 0 : 1 + ((u.pm - 32) >> 2);
        const float* gate = gate_base + bk * 9216;
        const float* xin = u.pm < 32 ? xin_ctx : xin_lat; const size_t xoff = u.pm < 32 ? 0 : (size_t)8192 * 1024;
        const int col0 = u.pn * BM + wc * 32 + 4 * fq;
#pragma unroll
        for (int bj = 0; bj < 2; ++bj)
#pragma unroll
            for (int n = 0; n < 2; ++n) {
                const f32x4 gv = *(const f32x4*)(gate + col0 + bj * HALF + n * 16) * gs;
#pragma unroll
                for (int ai = 0; ai < 2; ++ai)
#pragma unroll
                    for (int m = 0; m < 4; ++m) {
                        const size_t off = (size_t)(u.pm * BM + ai * HALF + wr * 64 + m * 16 + fr) * 1024 + col0 + bj * HALF + n * 16;
                        const f32x4 xv = *(const f32x4*)(xin + (off - xoff));
                        *(f32x4*)(out + off) = xv + gv * acc[ai][bj][m][n];
                    }
            }
    }
};
struct EpiBf16P {
    static constexpr bool PERM = true, AFTER_DRAIN = false;
    bf16_t* O; int ldc;
    __device__ __forceinline__ void operator()(const f32x4 (&acc)[2][2][4][2], const Unit& u, int wr, int wc, int fr, int fq) const {
        const int row0 = u.pm * BM + wr * 64 + fr; const int col0 = u.pn * BM + wc * 32 + 8 * fq;
#pragma unroll
        for (int ai = 0; ai < 2; ++ai)
#pragma unroll
            for (int m = 0; m < 4; ++m) {
                bf16_t* rowp = O + (size_t)(row0 + ai * HALF + m * 16) * ldc + col0;
#pragma unroll
                for (int bj = 0; bj < 2; ++bj) { const f32x4 v0 = acc[ai][bj][m][0], v1 = acc[ai][bj][m][1];
                    u32x4 w; w.x = cvt_pk_bf16(v0[0], v0[1]); w.y = cvt_pk_bf16(v0[2], v0[3]); w.z = cvt_pk_bf16(v1[0], v1[1]); w.w = cvt_pk_bf16(v1[2], v1[3]);
                    *(u32x4*)(rowp + bj * HALF) = w; }
            }
    }
};
template <class Epi, class Sched, bool ALIGN_EPI = false, bool SP2 = false>
__device__ __forceinline__ void gemm_phase(PG8_LAS unsigned char* lds, const Gemm g, const Sched& S, const Epi& E) {
    int tid_ = threadIdx.x; asm volatile("" : "+v"(tid_));
    const int tid = tid_, wid = __builtin_amdgcn_readfirstlane(tid >> 6), lane = tid & 63, wr = wid >> 2, wc = wid & 3, fr = lane & 15, fq = lane >> 4;
    const int K = g.K, nt = K / BK;
    unsigned voffA[2], voffB[2];
#pragma unroll
    for (int i = 0; i < 2; ++i) { int R, C; stage_rc(tid * 16 + i * 8192, R, C); const int Rb = Epi::PERM ? ((R & ~31) + perm32(R & 31)) : R;
        voffA[i] = (unsigned)(R * K + C) * 2u; voffB[i] = (unsigned)(Rb * K + C) * 2u; }
    const size_t kstep = (size_t)(BK * 2);
    const size_t hstep = (size_t)HALF * K * 2;
    const size_t tstep = 2 * hstep;
    const unsigned ldsw = (unsigned)wid * 1024u;
    const int aoff = lds_byte(wr * 64 + fr, fq * 8), boff = lds_byte(wc * 32 + fr, fq * 8);
#define PG8_SA(b, h) (((b) * 2 + (h)) * HTB)
#define PG8_SB(b, h) ((4 + (b) * 2 + (h)) * HTB)
#define PG8_STAGE(bufoff, gbase, voff) do { _Pragma("unroll") for (int _i = 0; _i < 2; ++_i) \
        __builtin_amdgcn_global_load_lds((const unsigned*)((const char*)(gbase) + (voff)[_i]), (PG8_LAS unsigned*)(lds + (bufoff) + ldsw + _i * 8192), 16, 0, 0); } while (0)
#define PG8_LDA(dst, b, h) do { _Pragma("unroll") for (int m = 0; m < 4; ++m) _Pragma("unroll") for (int k = 0; k < 2; ++k) dst[m][k] = *(const PG8_LAS bf16x8*)(lds + PG8_SA(b, h) + aoff + m * 2048 + k * 1024); } while (0)
#define PG8_LDB(dst, b, h) do { _Pragma("unroll") for (int n = 0; n < 2; ++n) _Pragma("unroll") for (int k = 0; k < 2; ++k) dst[n][k] = *(const PG8_LAS bf16x8*)(lds + PG8_SB(b, h) + boff + n * 2048 + k * 1024); } while (0)
#define PG8_MMA(ai, bj, At, Bt) do { __builtin_amdgcn_s_setprio(1); _Pragma("unroll") for (int m = 0; m < 4; ++m) _Pragma("unroll") for (int n = 0; n < 2; ++n) _Pragma("unroll") for (int k = 0; k < 2; ++k) \
        acc[ai][bj][m][n] = __builtin_amdgcn_mfma_f32_16x16x32_bf16(Bt[n][k], At[m][k], acc[ai][bj][m][n], 0, 0, 0); __builtin_amdgcn_s_setprio(0); } while (0)
#define PG8_WAIT_V(n) asm volatile("s_waitcnt vmcnt(" #n ")" ::: "memory")
#define PG8_WAIT_L(n) asm volatile("s_waitcnt lgkmcnt(" #n ")" ::: "memory")
#define PG8_BAR __builtin_amdgcn_s_barrier()
#define PG8_SCHED __builtin_amdgcn_sched_barrier(0)
    Unit cur, nxt; int ui = 0;
    if (!S.next(0, cur)) return;
    f32x4 acc[2][2][4][2];
#pragma unroll
    for (int a = 0; a < 2; ++a)
#pragma unroll
        for (int b = 0; b < 2; ++b)
#pragma unroll
            for (int m = 0; m < 4; ++m)
#pragma unroll
                for (int n = 0; n < 2; ++n) acc[a][b][m][n] = (f32x4){0.f, 0.f, 0.f, 0.f};
    bf16x8 At[4][2], B0[2][2], B1[2][2];
    const char* cA = (const char*)g.A + (size_t)cur.pm * tstep; const char* cB = (const char*)g.Bt + (size_t)cur.pn * tstep;
    S.a_ready(cur);
    if constexpr (SP2) {
        PG8_STAGE(PG8_SB(0, 0), cB, voffB); PG8_STAGE(PG8_SB(0, 1), cB + hstep, voffB); PG8_STAGE(PG8_SA(0, 0), cA, voffA); PG8_STAGE(PG8_SA(0, 1), cA + hstep, voffA);
        if (wr == 1) PG8_BAR;
        PG8_WAIT_V(2); PG8_BAR;
        PG8_STAGE(PG8_SB(1, 0), cB + kstep, voffB); PG8_STAGE(PG8_SA(1, 0), cA + kstep, voffA); PG8_STAGE(PG8_SB(1, 1), cB + hstep + kstep, voffB);
        PG8_WAIT_V(6); PG8_BAR;
    } else {
        PG8_STAGE(PG8_SB(0, 0), cB, voffB); PG8_STAGE(PG8_SA(0, 0), cA, voffA); PG8_STAGE(PG8_SB(0, 1), cB + hstep, voffB); PG8_STAGE(PG8_SA(0, 1), cA + hstep, voffA);
        if (wr == 1) PG8_BAR;
        PG8_WAIT_V(4); PG8_BAR;
        PG8_STAGE(PG8_SB(1, 0), cB + kstep, voffB); PG8_STAGE(PG8_SA(1, 0), cA + kstep, voffA); PG8_STAGE(PG8_SB(1, 1), cB + hstep + kstep, voffB);
        PG8_WAIT_V(6); PG8_BAR;
    }
    for (;;) {
        const bool has_next = S.next(ui + 1, nxt);
        const char* nA = has_next ? (const char*)g.A + (size_t)nxt.pm * tstep : cA; const char* nB = has_next ? (const char*)g.Bt + (size_t)nxt.pn * tstep : cB;
        for (int t = 0; t < nt; t += 2) {
            const bool last = (t == nt - 2);
            const char* a1 = cA + (size_t)(t + 1) * kstep;
            const char* a2 = last ? nA : cA + (size_t)(t + 2) * kstep; const char* b2 = last ? nB : cB + (size_t)(t + 2) * kstep;
            const char* a3 = a2 + kstep; const char* b3 = b2 + kstep;
            if (last && has_next) S.a_ready(nxt);
            if constexpr (SP2) {
            PG8_LDB(B0, 0, 0); PG8_LDB(B1, 0, 1); PG8_SCHED; PG8_LDA(At, 0, 0); PG8_STAGE(PG8_SA(1, 1), a1 + hstep, voffA);
            PG8_WAIT_V(8); PG8_WAIT_L(0); PG8_BAR; PG8_MMA(0, 0, At, B0); PG8_MMA(0, 1, At, B1); PG8_BAR; PG8_SCHED;
            PG8_LDA(At, 0, 1); PG8_STAGE(PG8_SB(0, 0), b2, voffB); PG8_STAGE(PG8_SB(0, 1), b2 + hstep, voffB); PG8_STAGE(PG8_SA(0, 0), a2, voffA);
            PG8_WAIT_V(8); PG8_WAIT_L(0); PG8_BAR; PG8_MMA(1, 0, At, B0); PG8_MMA(1, 1, At, B1); PG8_BAR; PG8_SCHED;
            PG8_LDB(B0, 1, 0); PG8_LDB(B1, 1, 1); PG8_SCHED; PG8_LDA(At, 1, 0); PG8_STAGE(PG8_SA(0, 1), a2 + hstep, voffA);
            PG8_WAIT_V(8); PG8_WAIT_L(0); PG8_BAR; PG8_MMA(0, 0, At, B0); PG8_MMA(0, 1, At, B1); PG8_BAR; PG8_SCHED;
            PG8_LDA(At, 1, 1); PG8_STAGE(PG8_SB(1, 0), b3, voffB); PG8_STAGE(PG8_SB(1, 1), b3 + hstep, voffB); PG8_STAGE(PG8_SA(1, 0), a3, voffA);
            PG8_WAIT_V(8); PG8_WAIT_L(0); PG8_BAR; PG8_MMA(1, 0, At, B0); PG8_MMA(1, 1, At, B1); PG8_BAR; PG8_SCHED;
            } else {
            PG8_LDB(B0, 0, 0); PG8_SCHED; PG8_LDA(At, 0, 0); PG8_STAGE(PG8_SA(1, 1), a1 + hstep, voffA);
            PG8_WAIT_L(8); PG8_BAR; PG8_WAIT_L(0); PG8_MMA(0, 0, At, B0); PG8_BAR; PG8_SCHED;
            PG8_LDB(B1, 0, 1); PG8_STAGE(PG8_SB(0, 0), b2, voffB);
            PG8_BAR; PG8_WAIT_L(0); PG8_MMA(0, 1, At, B1); PG8_BAR;
            PG8_LDA(At, 0, 1); PG8_STAGE(PG8_SA(0, 0), a2, voffA);
            PG8_BAR; PG8_WAIT_L(0); PG8_MMA(1, 0, At, B0); PG8_BAR; PG8_SCHED;
            PG8_STAGE(PG8_SB(0, 1), b2 + hstep, voffB);
            PG8_WAIT_V(6); PG8_BAR; PG8_MMA(1, 1, At, B1); PG8_BAR;
            PG8_LDB(B0, 1, 0); PG8_SCHED; PG8_LDA(At, 1, 0); PG8_STAGE(PG8_SA(0, 1), a2 + hstep, voffA);
            PG8_WAIT_L(8); PG8_BAR; PG8_WAIT_L(0); PG8_MMA(0, 0, At, B0); PG8_BAR; PG8_SCHED;
            PG8_LDB(B1, 1, 1); PG8_STAGE(PG8_SB(1, 0), b3, voffB);
            PG8_BAR; PG8_WAIT_L(0); PG8_MMA(0, 1, At, B1); PG8_BAR;
            PG8_LDA(At, 1, 1); PG8_STAGE(PG8_SA(1, 0), a3, voffA);
            PG8_BAR; PG8_WAIT_L(0); PG8_MMA(1, 0, At, B0); PG8_BAR; PG8_SCHED;
            PG8_STAGE(PG8_SB(1, 1), b3 + hstep, voffB);
            PG8_WAIT_V(6); PG8_BAR; PG8_MMA(1, 1, At, B1); PG8_BAR;
            }
        }
        if constexpr (ALIGN_EPI) { if (wr == 0) PG8_BAR; }
        if constexpr (!Epi::AFTER_DRAIN) { E(acc, cur, wr, wc, fr, fq); S.done(cur); }
        if (!has_next) break;
#pragma unroll
        for (int a = 0; a < 2; ++a)
#pragma unroll
            for (int b = 0; b < 2; ++b)
#pragma unroll
                for (int m = 0; m < 4; ++m)
#pragma unroll
                    for (int n = 0; n < 2; ++n) acc[a][b][m][n] = (f32x4){0.f, 0.f, 0.f, 0.f};
        cur = nxt; cA = nA; cB = nB; ++ui;
        if constexpr (ALIGN_EPI) { if (wr == 1) PG8_BAR; }
    }
    PG8_WAIT_V(0);
    if constexpr (!ALIGN_EPI) { if (wr == 0) PG8_BAR; }
    PG8_BAR;
    if constexpr (Epi::AFTER_DRAIN) { E.fused(acc, cur, wr, wc, fr, fq, lds, wid, lane); S.done(cur); }
#undef PG8_SA
#undef PG8_SB
#undef PG8_STAGE
#undef PG8_LDA
#undef PG8_LDB
#undef PG8_MMA
#undef PG8_WAIT_V
#undef PG8_WAIT_L
#undef PG8_BAR
#undef PG8_SCHED
}
}
#define LAS __attribute__((address_space(3)))
typedef unsigned short bf16;
typedef unsigned v4u __attribute__((ext_vector_type(4)));
typedef unsigned v2u __attribute__((ext_vector_type(2)));
typedef float f32x4 __attribute__((ext_vector_type(4)));
typedef short bf16x8 __attribute__((ext_vector_type(8)));
typedef short s16x4 __attribute__((ext_vector_type(4)));

constexpr int NWAVES = 8, NTHR = 512;
constexpr int LDS_BYTES = 147456;
constexpr int D = 1024, MTOK = 16384, MCTX = 8192, NKEYROWS = 18432, DFF = 2816, PCOLS = 2816;
constexpr float EPS = 1e-6f;
constexpr size_t MiB = 1u << 20;
constexpr size_t WS_CTL = 0, WS_MOD = 1 * MiB, WS_ROPE = 1 * MiB + 768 * 1024;
constexpr size_t WS_WT13A = 2 * MiB, WS_WT13B = 13 * MiB, WS_WT2A = 24 * MiB, WS_WT2B = 24 * MiB + 5632 * 1024, WS_WTIN = 35 * MiB;
constexpr size_t WS_WTUQ = 40 * MiB + 512 * 1024, WS_WTUKV = 41 * MiB + 256 * 1024, WS_WTOUT = 42 * MiB;
constexpr size_t WS_PH = 44 * MiB, WS_U = 132 * MiB, WS_CQN = 164 * MiB, WS_CKV = 176 * MiB, WS_KR = 185 * MiB, WS_KB = 187 * MiB, WS_VB = 196 * MiB;
constexpr size_t WS_QB = 205 * MiB, WS_QA = 213 * MiB, WS_KNV = 237 * MiB, WS_OCB = 264 * MiB, WS_END = 276 * MiB;
constexpr size_t O_X = 0, O_CKV = 16777216, O_KR = 20971520, O_DK = 21495808, O_DV = 25690112, O_SF = 29884416, O_SB = 31064064;
constexpr int PC_CQ = 0, PC_CKV = 384, PC_KR = 640, PC_QB = 672, PC_KB = 928, PC_VB = 1184, PC_GQ = 1440, PC_GK = 1632, PC_GV = 1824, PC_RC = 2208, PC_GLF = 2592;

enum { I_XP = 0, I_XS, I_CCKV, I_CKR, I_CDK, I_CDV, I_SF, I_SB, I_C, I_CCTX, I_WMOD, I_BMOD, I_NF1, I_F1W13, I_F1W2, I_NMIX, I_WIN, I_QNORM, I_WUQ, I_KVNORM,
       I_WUK, I_WUV, I_ONORM, I_LQ1, I_LK1, I_LQ2, I_LK2, I_DNORM, I_WGF, I_BGF, I_WGB, I_BGB, I_GNORM, I_WOUT, I_NF2, I_F2W13, I_F2W2, I_FNORM, N_IN };

struct Args { const float* in[N_IN]; float* out; unsigned char* ws; };

__device__ __forceinline__ float bf2f(unsigned short h) { return __uint_as_float((unsigned)h << 16); }
__device__ __forceinline__ float bflo(unsigned w) { return __uint_as_float(w << 16); }
__device__ __forceinline__ float bfhi(unsigned w) { return __uint_as_float(w & 0xffff0000u); }
__device__ __forceinline__ unsigned pk2(float lo, float hi) { return pg8::cvt_pk_bf16(lo, hi); }
__device__ __forceinline__ unsigned short f2bf(float f) { return (unsigned short)(pk2(f, 0.f) & 0xffffu); }
__device__ __forceinline__ float wave_sum(float v) {
#pragma unroll
    for (int o = 1; o < 64; o <<= 1) v += __shfl_xor(v, o);
    return v;
}
__device__ __forceinline__ float grp16_sum(float v) {
#pragma unroll
    for (int o = 1; o < 16; o <<= 1) v += __shfl_xor(v, o);
    return v;
}
__device__ __forceinline__ f32x4 mfma16(bf16x8 a, bf16x8 b, f32x4 c) { return __builtin_amdgcn_mfma_f32_16x16x32_bf16(a, b, c, 0, 0, 0); }
typedef short v4i16_t __attribute__((ext_vector_type(4)));
__device__ __forceinline__ s16x4 vtr(LAS const unsigned char* p) { return __builtin_bit_cast(s16x4, __builtin_amdgcn_ds_read_tr16_b64_v4i16((LAS v4i16_t*)p)); }

typedef const float* cfp_t;
typedef __attribute__((address_space(4))) const cfp_t* inptr_t;
struct Frame {
    LAS unsigned char* lds;
    int tid, lane, wave, G, gw, ngw;
    inptr_t in; float* out; unsigned char* ws;
};

__device__ __forceinline__ void transpose_item(const float* W, int K, int N, bf16* WT, int row_off, LAS float* scr, int kb, int nb, int lane) {
    const int k0 = 64 * kb, n0 = 32 * nb;
#pragma unroll 8
    for (int i = 0; i < 32; ++i) { const int kk = 2 * i + (lane >> 5); scr[kk * 33 + (lane & 31)] = W[(size_t)(k0 + kk) * N + n0 + (lane & 31)]; }
    asm volatile("s_waitcnt lgkmcnt(0)" ::: "memory");
    const int c = lane & 7;
#pragma unroll
    for (int j = 0; j < 4; ++j) { const int n = (lane >> 3) + 8 * j; const LAS float* s = scr + (8 * c) * 33 + n;
        v4u o; o.x = pk2(s[0 * 33], s[1 * 33]); o.y = pk2(s[2 * 33], s[3 * 33]); o.z = pk2(s[4 * 33], s[5 * 33]); o.w = pk2(s[6 * 33], s[7 * 33]);
        *(v4u*)(WT + (size_t)(row_off + n0 + n) * K + k0 + 8 * c) = o; }
    asm volatile("s_waitcnt lgkmcnt(0)" ::: "memory");
}

__device__ __forceinline__ void prep_phase(Frame& F, int l) {
    LAS float* scr = (LAS float*)(F.lds + F.wave * 8704);
    unsigned char* ws = F.ws;
    constexpr int I13 = 16 * 176, I2 = 44 * 32, IIN = 16 * 82, IUQ = 6 * 18, IUK = 4 * 12, IOUT = 16 * 32;
    constexpr int NIT = 2 * I13 + 2 * I2 + IIN + IUQ + 2 * IUK + IOUT;
    for (int it = F.gw; it < NIT; it += F.ngw) {
        int r = it;
        if (r < 2 * I13) { const int f = r >= I13; r -= f * I13; const int kb = r / 176, nb = r % 176; const int n0 = 32 * nb; const int half = n0 >= DFF; const int j = n0 - half * DFF;
            const int orow = 256 * (j >> 7) + 128 * half + (j & 127);
            transpose_item(F.in[f ? I_F2W13 : I_F1W13] + (size_t)l * 1024 * 5632, 1024, 5632, (bf16*)(ws + (f ? WS_WT13B : WS_WT13A)), orow - n0, scr, kb, nb, F.lane); continue; }
        r -= 2 * I13;
        if (r < 2 * I2) { const int f = r >= I2; r -= f * I2; transpose_item(F.in[f ? I_F2W2 : I_F1W2] + (size_t)l * DFF * 1024, DFF, 1024, (bf16*)(ws + (f ? WS_WT2B : WS_WT2A)), 0, scr, r / 32, r % 32, F.lane); continue; }
        r -= 2 * I2;
        if (r < IIN) { transpose_item(F.in[I_WIN] + (size_t)l * 1024 * 2624, 1024, 2624, (bf16*)(ws + WS_WTIN), 0, scr, r / 82, r % 82, F.lane); continue; }
        r -= IIN;
        if (r < IUQ) { transpose_item(F.in[I_WUQ] + (size_t)l * 384 * 576, 384, 576, (bf16*)(ws + WS_WTUQ), 0, scr, r / 18, r % 18, F.lane); continue; }
        r -= IUQ;
        if (r < 2 * IUK) { const int f = r >= IUK; r -= f * IUK; transpose_item(F.in[f ? I_WUV : I_WUK] + (size_t)l * 256 * 384, 256, 384, (bf16*)(ws + WS_WTUKV), f * 384, scr, r / 12, r % 12, F.lane); continue; }
        r -= 2 * IUK;
        transpose_item(F.in[I_WOUT] + (size_t)l * 1024 * 1024, 1024, 1024, (bf16*)(ws + WS_WTOUT), 0, scr, r / 32, r % 32, F.lane);
    }
    { const int gt = blockIdx.x * NTHR + F.tid, ngt = F.G * NTHR;
      v4u z = {0u, 0u, 0u, 0u};
      v4u* p1 = (v4u*)(ws + WS_WTIN + (size_t)2624 * 1024 * 2); for (int i = gt; i < 192 * 1024 * 2 / 16; i += ngt) p1[i] = z;
      v4u* p2 = (v4u*)(ws + WS_WTUQ + (size_t)576 * 384 * 2); for (int i = gt; i < 192 * 384 * 2 / 16; i += ngt) p2[i] = z; }
    if (l != 0) return;
    if (blockIdx.x == F.G - 1) { const int pos = F.tid >> 3, i = F.tid & 7; const float inv = exp2f(-(float)i * 1.6609640474436813f);
        const float rev = (float)pos * inv * 0.15915494309189535f; float* R = (float*)(ws + WS_ROPE);
        R[F.tid * 2] = __builtin_amdgcn_cosf(rev); R[F.tid * 2 + 1] = __builtin_amdgcn_sinf(rev); }
    LAS float* sc = (LAS float*)(F.lds + 69632);
    LAS float* part = (LAS float*)(F.lds + 106496);
    __syncthreads();
    for (int i = F.tid; i < 9 * 1024; i += NTHR) { const int b = i >> 10, k = i & 1023; const float c = b == 0 ? F.in[I_CCTX][k] : F.in[I_C][(b - 1) * 1024 + k]; sc[i] = c / (1.0f + __expf(-c)); }
    __syncthreads();
    float* MOD = (float*)(ws + WS_MOD);
    for (int j = blockIdx.x; j < 288; j += F.G) {
        const int ll = j / 144, c0 = (j % 144) * 64;
        const float* wp = F.in[I_WMOD] + (size_t)ll * 1024 * 9216 + (size_t)(F.wave * 128) * 9216 + c0 + F.lane;
        float a0 = 0.f, a1 = 0.f, a2 = 0.f, a3 = 0.f, a4 = 0.f, a5 = 0.f, a6 = 0.f, a7 = 0.f, a8 = 0.f;
#pragma unroll 8
        for (int kk = 0; kk < 128; ++kk) { const float w = wp[(size_t)kk * 9216]; const LAS float* s = sc + F.wave * 128 + kk;
            a0 += s[0] * w; a1 += s[1024] * w; a2 += s[2048] * w; a3 += s[3072] * w; a4 += s[4096] * w; a5 += s[5120] * w; a6 += s[6144] * w; a7 += s[7168] * w; a8 += s[8192] * w; }
        LAS float* pp = part + F.wave * 576 + F.lane;
        pp[0] = a0; pp[64] = a1; pp[128] = a2; pp[192] = a3; pp[256] = a4; pp[320] = a5; pp[384] = a6; pp[448] = a7; pp[512] = a8;
        __syncthreads();
        for (int i = F.tid; i < 576; i += NTHR) { float s = 0.f;
#pragma unroll
            for (int w = 0; w < 8; ++w) s += part[w * 576 + i];
            const int b = i >> 6, c = i & 63; MOD[(size_t)(ll * 9 + b) * 9216 + c0 + c] = s + F.in[I_BMOD][ll * 9216 + c0 + c]; }
        __syncthreads();
    }
}

__device__ __forceinline__ void norm_phase(Frame& F, const float* xc, const float* xl, const float* gain, const float* modl, int ni, bf16* U) {
    for (int m = F.gw; m < MTOK; m += F.ngw) {
        const float* xr = m < MCTX ? xc + (size_t)m * D : xl + (size_t)(m - MCTX) * D;
        const int bk = m < MCTX ? 0 : 1 + ((m - MCTX) >> 10);
        const float* sh = modl + bk * 9216 + (3 * ni) * 1024; const float* sc = sh + 1024;
        f32x4 v[4]; float ss = 0.f;
#pragma unroll
        for (int j = 0; j < 4; ++j) { v[j] = *(const f32x4*)(xr + 4 * F.lane + 256 * j); ss += (v[j].x * v[j].x + v[j].y * v[j].y) + (v[j].z * v[j].z + v[j].w * v[j].w); }
        const float rstd = rsqrtf(wave_sum(ss) * (1.0f / D) + EPS);
#pragma unroll
        for (int j = 0; j < 4; ++j) { const int k = 4 * F.lane + 256 * j;
            const f32x4 g = *(const f32x4*)(gain + k), s1 = *(const f32x4*)(sc + k), s0 = *(const f32x4*)(sh + k);
            const f32x4 y = v[j] * rstd * g * (s1 + 1.0f) + s0;
            v2u o; o.x = pk2(y.x, y.y); o.y = pk2(y.z, y.w); *(v2u*)(U + (size_t)m * D + k) = o; }
    }
}
__device__ __forceinline__ void final_norm_phase(Frame& F, float* X, const float* gain) {
    for (int m = F.gw; m < MTOK; m += F.ngw) {
        float* xr = X + (size_t)m * D;
        f32x4 v[4]; float ss = 0.f;
#pragma unroll
        for (int j = 0; j < 4; ++j) { v[j] = *(const f32x4*)(xr + 4 * F.lane + 256 * j); ss += (v[j].x * v[j].x + v[j].y * v[j].y) + (v[j].z * v[j].z + v[j].w * v[j].w); }
        const float rstd = rsqrtf(wave_sum(ss) * (1.0f / D) + EPS);
#pragma unroll
        for (int j = 0; j < 4; ++j) { const int k = 4 * F.lane + 256 * j; const f32x4 g = *(const f32x4*)(gain + k); *(f32x4*)(xr + k) = v[j] * rstd * g; }
    }
}

__device__ __forceinline__ void rope4(float (&x)[4], int lane, int t, const float* R) {
    const int part = (lane & 7) >> 2, second = (lane & 3) >> 1, i0 = (lane & 1) * 4; const int pos = part ? (t & 63) : (t >> 6);
#pragma unroll
    for (int e = 0; e < 4; ++e) { const float xp = __shfl_xor(x[e], 2); const float c = R[(pos * 8 + i0 + e) * 2], s = R[(pos * 8 + i0 + e) * 2 + 1];
        x[e] = second ? (xp * s + x[e] * c) : (x[e] * c - xp * s); }
}
__device__ __forceinline__ void postproj_phase(Frame& F, int l) {
    unsigned char* ws = F.ws; const bf16* P = (const bf16*)(ws + WS_PH); const float* R = (const float*)(ws + WS_ROPE);
    bf16* CQN = (bf16*)(ws + WS_CQN); bf16* CKV = (bf16*)(ws + WS_CKV); bf16* KR = (bf16*)(ws + WS_KR); bf16* KB = (bf16*)(ws + WS_KB); bf16* VB = (bf16*)(ws + WS_VB); bf16* QB = (bf16*)(ws + WS_QB);
    const float* qn = F.in[I_QNORM] + l * 384; const float* kvn = F.in[I_KVNORM] + l * 256;
    const int lane = F.lane;
    for (int m = F.gw; m < MTOK + 2048; m += F.ngw) {
        if (m < MTOK) {
            const bf16* pr = P + (size_t)m * PCOLS;
            const bool isctx = m < MCTX; const int b = isctx ? (m >> 8) : ((m - MCTX) >> 10), t = isctx ? (m & 255) : ((m - MCTX) & 1023);
            const int keyrow = isctx ? m : MCTX + b * 1280 + 256 + t; const size_t orow = (size_t)((b * 2 + l) * 256 + t);
            {
                unsigned w[3]; float ss = 0.f;
#pragma unroll
                for (int j = 0; j < 3; ++j) { w[j] = *(const unsigned*)(pr + PC_CQ + 2 * lane + 128 * j); const float a = bflo(w[j]), c = bfhi(w[j]); ss += a * a + c * c; }
                const float rstd = rsqrtf(wave_sum(ss) * (1.0f / 384.0f) + EPS);
#pragma unroll
                for (int j = 0; j < 3; ++j) { const int idx = 2 * lane + 128 * j; *(unsigned*)(CQN + (size_t)m * 384 + idx) = pk2(bflo(w[j]) * rstd * qn[idx], bfhi(w[j]) * rstd * qn[idx + 1]); }
            }
            {
                const v2u w = *(const v2u*)(pr + PC_CKV + 4 * lane); float x[4] = {bflo(w.x), bfhi(w.x), bflo(w.y), bfhi(w.y)};
                const float ss = (x[0] * x[0] + x[1] * x[1]) + (x[2] * x[2] + x[3] * x[3]);
                const float rstd = rsqrtf(wave_sum(ss) * (1.0f / 256.0f) + EPS);
                const f32x4 g = *(const f32x4*)(kvn + 4 * lane); f32x4 y = {x[0] * rstd * g.x, x[1] * rstd * g.y, x[2] * rstd * g.z, x[3] * rstd * g.w};
                if (isctx) *(f32x4*)(F.out + O_CKV + orow * 256 + 4 * lane) = y;
                v2u o; o.x = pk2(y.x, y.y); o.y = pk2(y.z, y.w); *(v2u*)(CKV + (size_t)keyrow * 256 + 4 * lane) = o;
            }
            {
                const int j = lane & 31; float x = bf2f(pr[PC_KR + j]); const float xp = __shfl_xor(x, 8);
                if (!isctx) { const int part = j >> 4, i = j & 7, second = (j >> 3) & 1; const int pos = part ? (t & 63) : (t >> 6);
                    const float c = R[(pos * 8 + i) * 2], s = R[(pos * 8 + i) * 2 + 1]; x = second ? (xp * s + x * c) : (x * c - xp * s); }
                if (lane < 32) { if (isctx) F.out[O_KR + orow * 32 + lane] = x; KR[(size_t)keyrow * 32 + lane] = f2bf(x); }
            }
            {
                const v2u w = *(const v2u*)(pr + PC_QB + 4 * lane); float x[4] = {bflo(w.x), bfhi(w.x), bflo(w.y), bfhi(w.y)};
                if (!isctx) rope4(x, lane, t, R);
                v2u o; o.x = pk2(x[0], x[1]); o.y = pk2(x[2], x[3]); *(v2u*)(QB + (size_t)m * 256 + 4 * lane) = o;
            }
            {
                const v2u w = *(const v2u*)(pr + PC_KB + 4 * lane); float x[4] = {bflo(w.x), bfhi(w.x), bflo(w.y), bfhi(w.y)};
                if (isctx) *(f32x4*)(F.out + O_DK + orow * 256 + 4 * lane) = (f32x4){x[0], x[1], x[2], x[3]};
                else rope4(x, lane, t, R);
                v2u o; o.x = pk2(x[0], x[1]); o.y = pk2(x[2], x[3]); *(v2u*)(KB + (size_t)keyrow * 256 + 4 * lane) = o;
            }
            {
                const v2u w = *(const v2u*)(pr + PC_VB + 4 * lane);
                if (isctx) *(f32x4*)(F.out + O_DV + orow * 256 + 4 * lane) = (f32x4){bflo(w.x), bfhi(w.x), bflo(w.y), bfhi(w.y)};
                *(v2u*)(VB + (size_t)keyrow * 256 + 4 * lane) = w;
            }
        } else {
            const int r = m - MTOK, b = r >> 8, j = r & 255; const int keyrow = MCTX + b * 1280 + j; const size_t src = (size_t)((b * 2 + l) * 256 + j);
            { const f32x4 x = *(const f32x4*)(F.in[I_CCKV] + src * 256 + 4 * lane); v2u o; o.x = pk2(x.x, x.y); o.y = pk2(x.z, x.w); *(v2u*)(CKV + (size_t)keyrow * 256 + 4 * lane) = o; }
            if (lane < 32) KR[(size_t)keyrow * 32 + lane] = f2bf(F.in[I_CKR][src * 32 + lane]);
            { const f32x4 x = *(const f32x4*)(F.in[I_CDK] + src * 256 + 4 * lane); v2u o; o.x = pk2(x.x, x.y); o.y = pk2(x.z, x.w); *(v2u*)(KB + (size_t)keyrow * 256 + 4 * lane) = o; }
            { const f32x4 x = *(const f32x4*)(F.in[I_CDV] + src * 256 + 4 * lane); v2u o; o.x = pk2(x.x, x.y); o.y = pk2(x.z, x.w); *(v2u*)(VB + (size_t)keyrow * 256 + 4 * lane) = o; }
        }
    }
}

template <int KS>
__device__ __forceinline__ void attn_tile(const bf16x8 (&qf)[KS], LAS const unsigned char* Kt, int kstr, LAS const unsigned char* Vt, int vstr, float sl2, float& m_, float& l_, f32x4 (&O)[4], int lane) {
    const int r = lane & 15, g = lane >> 4;
    f32x4 s[4];
#pragma unroll
    for (int kt = 0; kt < 4; ++kt) {
        s[kt] = (f32x4){0.f, 0.f, 0.f, 0.f};
        LAS const unsigned char* kp = Kt + (kt * 16 + r) * kstr + g * 16;
#pragma unroll
        for (int ks = 0; ks < KS; ++ks) { const bf16x8 a = *(LAS const bf16x8*)(kp + ks * 64); s[kt] = mfma16(a, qf[ks], s[kt]); }
    }
    float mx = s[0][0];
#pragma unroll
    for (int kt = 0; kt < 4; ++kt)
#pragma unroll
        for (int j = 0; j < 4; ++j) mx = fmaxf(mx, s[kt][j]);
    mx = fmaxf(mx, __shfl_xor(mx, 16)); mx = fmaxf(mx, __shfl_xor(mx, 32));
    const float mn = fmaxf(m_, mx * sl2);
    const float alpha = __builtin_amdgcn_exp2f(m_ - mn);
    float ps = 0.f;
#pragma unroll
    for (int kt = 0; kt < 4; ++kt)
#pragma unroll
        for (int j = 0; j < 4; ++j) { const float p = __builtin_amdgcn_exp2f(s[kt][j] * sl2 - mn); s[kt][j] = p; ps += p; }
    ps += __shfl_xor(ps, 16); ps += __shfl_xor(ps, 32);
    l_ = l_ * alpha + ps; m_ = mn;
#pragma unroll
    for (int dt = 0; dt < 4; ++dt) O[dt] = O[dt] * alpha;
#pragma unroll
    for (int kb = 0; kb < 2; ++kb) {
        v4u pw; pw.x = pk2(s[2 * kb][0], s[2 * kb][1]); pw.y = pk2(s[2 * kb][2], s[2 * kb][3]); pw.z = pk2(s[2 * kb + 1][0], s[2 * kb + 1][1]); pw.w = pk2(s[2 * kb + 1][2], s[2 * kb + 1][3]);
        const bf16x8 pf = __builtin_bit_cast(bf16x8, pw);
#pragma unroll
        for (int dt = 0; dt < 4; ++dt) {
            LAS const unsigned char* vp = Vt + (32 * kb + 4 * g + (r >> 2)) * vstr + (16 * dt + 4 * (r & 3)) * 2;
            const s16x4 lo = vtr(vp), hi = vtr(vp + 16 * vstr);
            const bf16x8 vf = {lo[0], lo[1], lo[2], lo[3], hi[0], hi[1], hi[2], hi[3]};
            O[dt] = mfma16(vf, pf, O[dt]);
        }
    }
}

constexpr int KSTR_A = 208, VSTR = 144, KSTR_B = 144;
constexpr int ATT_K_OFF = 0, ATT_V_OFF = 16384;

__device__ __forceinline__ void mla_unit(Frame& F, int l, bool lat, int b, int h, int qt) {
    unsigned char* ws = F.ws; const bf16* QA = (const bf16*)(ws + WS_QA); const bf16* KNV = (const bf16*)(ws + WS_KNV); const bf16* KR = (const bf16*)(ws + WS_KR); bf16* MIX = (bf16*)(ws + WS_U);
    const int tok0 = lat ? MCTX + b * 1024 + qt * 128 : b * 256 + qt * 128, keyrow0 = lat ? MCTX + b * 1280 : b * 256, NK = lat ? 1280 : 256;
    const int lane = F.lane, r = lane & 15, g = lane >> 4, tid = F.tid; const int trow = tok0 + 16 * F.wave + r;
    LAS unsigned char* Kt = F.lds + ATT_K_OFF; LAS unsigned char* Vt = F.lds + ATT_V_OFF;
    const bf16* s0 = KNV + (size_t)(keyrow0 + (tid >> 3)) * 768 + h * 64 + (tid & 7) * 8; LAS unsigned char* d0 = Kt + (tid >> 3) * KSTR_A + (tid & 7) * 16;
    const bf16* s1; LAS unsigned char* d1; size_t st1;
    if (tid < 256) { s1 = KR + (size_t)(keyrow0 + (tid >> 2)) * 32 + (tid & 3) * 8; d1 = Kt + (tid >> 2) * KSTR_A + 128 + (tid & 3) * 16; st1 = 64 * 32; }
    else { const int cc = tid - 256; s1 = KNV + (size_t)(keyrow0 + (cc >> 3)) * 768 + 384 + h * 64 + (cc & 7) * 8; d1 = Vt + (cc >> 3) * VSTR + (cc & 7) * 16; st1 = 64 * 768; }
    const int c2 = (tid & 255) + 256; const bf16* s2 = KNV + (size_t)(keyrow0 + (c2 >> 3)) * 768 + 384 + h * 64 + (c2 & 7) * 8; LAS unsigned char* d2 = Vt + (c2 >> 3) * VSTR + (c2 & 7) * 16;
    v4u p0 = *(const v4u*)s0, p1 = *(const v4u*)s1, p2 = *(const v4u*)s2;
    bf16x8 qf[3];
#pragma unroll
    for (int ks = 0; ks < 3; ++ks) qf[ks] = *(const bf16x8*)(QA + (size_t)trow * 768 + h * 96 + 32 * ks + 8 * g);
    if (lat) {
        const float* R = (const float*)(ws + WS_ROPE); const int t = qt * 128 + 16 * F.wave + r; const int pos = g < 2 ? (t >> 6) : (t & 63);
        const v4u me = __builtin_bit_cast(v4u, qf[2]); v4u pa; float o[8];
#pragma unroll
        for (int d = 0; d < 4; ++d) pa[d] = (unsigned)__shfl_xor((int)me[d], 16);
#pragma unroll
        for (int i = 0; i < 8; ++i) { const float x = (i & 1) ? bfhi(me[i >> 1]) : bflo(me[i >> 1]), xp = (i & 1) ? bfhi(pa[i >> 1]) : bflo(pa[i >> 1]);
            const float c = R[(pos * 8 + i) * 2], s = R[(pos * 8 + i) * 2 + 1]; o[i] = (g & 1) ? (xp * s + x * c) : (x * c - xp * s); }
        v4u w; w.x = pk2(o[0], o[1]); w.y = pk2(o[2], o[3]); w.z = pk2(o[4], o[5]); w.w = pk2(o[6], o[7]); qf[2] = __builtin_bit_cast(bf16x8, w);
    }
    float m_ = -1e30f, l_ = 0.f; f32x4 O[4];
#pragma unroll
    for (int dt = 0; dt < 4; ++dt) O[dt] = (f32x4){0.f, 0.f, 0.f, 0.f};
    const float sl2 = 0.10206207261596575f * 1.4426950408889634f;
    for (int k0 = 0; k0 < NK; k0 += 64) {
        __syncthreads();
        *(LAS v4u*)d0 = p0; *(LAS v4u*)d1 = p1; if (tid < 256) *(LAS v4u*)d2 = p2;
        __syncthreads();
        if (k0 + 64 < NK) { s0 += 64 * 768; s1 += st1; s2 += 64 * 768; p0 = *(const v4u*)s0; p1 = *(const v4u*)s1; p2 = *(const v4u*)s2; }
        attn_tile<3>(qf, Kt, KSTR_A, Vt, VSTR, sl2, m_, l_, O, lane);
    }
    const float il = 1.0f / l_;
#pragma unroll
    for (int dt = 0; dt < 4; ++dt) { v2u o; o.x = pk2(O[dt][0] * il, O[dt][1] * il); o.y = pk2(O[dt][2] * il, O[dt][3] * il);
        *(v2u*)(MIX + (size_t)trow * 1024 + h * 64 + 16 * dt + 4 * g) = o; }
}

__device__ __forceinline__ void diff_unit(Frame& F, int l, bool lat, int b, int h, int qt) {
    unsigned char* ws = F.ws; const bf16* QB = (const bf16*)(ws + WS_QB); const bf16* KB = (const bf16*)(ws + WS_KB); const bf16* VB = (const bf16*)(ws + WS_VB); bf16* MIX = (bf16*)(ws + WS_U);
    const int tok0 = lat ? MCTX + b * 1024 + qt * 128 : b * 256 + qt * 128, keyrow0 = lat ? MCTX + b * 1280 : b * 256, NK = lat ? 1280 : 256;
    const int lane = F.lane, r = lane & 15, g = lane >> 4, tid = F.tid; const int trow = tok0 + 16 * F.wave + r;
    LAS unsigned char* Kt = F.lds + ATT_K_OFF; LAS unsigned char* Vt = F.lds + ATT_V_OFF;
    const bf16* s0 = KB + (size_t)(keyrow0 + (tid >> 3)) * 256 + h * 64 + (tid & 7) * 8; LAS unsigned char* d0 = Kt + (tid >> 3) * KSTR_B + (tid & 7) * 16;
    const bf16* s1 = VB + (size_t)(keyrow0 + (tid >> 3)) * 256 + h * 64 + (tid & 7) * 8; LAS unsigned char* d1 = Vt + (tid >> 3) * VSTR + (tid & 7) * 16;
    v4u p0 = *(const v4u*)s0, p1 = *(const v4u*)s1;
    bf16x8 q0[1], q1[1];
    q0[0] = *(const bf16x8*)(QB + (size_t)trow * 256 + h * 64 + 8 * g); q1[0] = *(const bf16x8*)(QB + (size_t)trow * 256 + h * 64 + 32 + 8 * g);
    float m0 = -1e30f, l0 = 0.f, m1 = -1e30f, l1 = 0.f; f32x4 O0[4], O1[4];
#pragma unroll
    for (int dt = 0; dt < 4; ++dt) { O0[dt] = (f32x4){0.f, 0.f, 0.f, 0.f}; O1[dt] = (f32x4){0.f, 0.f, 0.f, 0.f}; }
    const float sl2 = 0.17677669529663687f * 1.4426950408889634f;
    for (int k0 = 0; k0 < NK; k0 += 64) {
        __syncthreads();
        *(LAS v4u*)d0 = p0; *(LAS v4u*)d1 = p1;
        __syncthreads();
        if (k0 + 64 < NK) { s0 += 64 * 256; s1 += 64 * 256; p0 = *(const v4u*)s0; p1 = *(const v4u*)s1; }
        attn_tile<1>(q0, Kt, KSTR_B, Vt, VSTR, sl2, m0, l0, O0, lane);
        attn_tile<1>(q1, Kt + 64, KSTR_B, Vt, VSTR, sl2, m1, l1, O1, lane);
    }
    float d1_ = 0.f, d2_ = 0.f;
#pragma unroll 4
    for (int i = 0; i < 32; ++i) { d1_ += F.in[I_LQ1][l * 32 + i] * F.in[I_LK1][l * 32 + i]; d2_ += F.in[I_LQ2][l * 32 + i] * F.in[I_LK2][l * 32 + i]; }
    const float lam = expf(d1_) - expf(d2_) + (l == 0 ? 0.2f : (0.8f - 0.6f * 0.7408182206817179f));
    const float i0 = 1.0f / l0, i1 = lam / l1;
#pragma unroll
    for (int dt = 0; dt < 4; ++dt) { v2u o; o.x = pk2(O0[dt][0] * i0 - O1[dt][0] * i1, O0[dt][1] * i0 - O1[dt][1] * i1); o.y = pk2(O0[dt][2] * i0 - O1[dt][2] * i1, O0[dt][3] * i0 - O1[dt][3] * i1);
        *(v2u*)(MIX + (size_t)trow * 1024 + 384 + h * 64 + 16 * dt + 4 * g) = o; }
}

constexpr int GL_RQ = 0, GL_RK = 6144, GL_RV = 12288, GL_RG = 25600, GL_T = 27648, GL_BL = 29184, GL_QE = 29440, GL_KE = 38656, GL_KDT = 47872, GL_ST = 54784, GL_AT = 68608, GL_STR = 144, GL_VSTR = 208;
__device__ __forceinline__ void gla_unit(Frame& F, int l, bool lat, int b, int h, int dir) {
    unsigned char* ws = F.ws; const bf16* P = (const bf16*)(ws + WS_PH); bf16* MIX = (bf16*)(ws + WS_U); bf16* OCB = (bf16*)(ws + WS_OCB);
    const int N = lat ? 1024 : 256, nc = N / 64, tokbase = lat ? MCTX + b * 1024 : b * 256;
    const int lane = F.lane, r = lane & 15, g = lane >> 4, w = F.wave, tid = F.tid;
    LAS unsigned char* L = F.lds;
    LAS float* T = (LAS float*)(L + GL_T); LAS float* BL = (LAS float*)(L + GL_BL);
    LAS unsigned char* QE = L + GL_QE; LAS unsigned char* KE = L + GL_KE; LAS unsigned char* KDT = L + GL_KDT; LAS unsigned char* ST = L + GL_ST; LAS unsigned char* AT = L + GL_AT; LAS unsigned char* RV = L + GL_RV;
    int soff[4]; int doff[4]; int srow[4];
#pragma unroll
    for (int i = 0; i < 4; ++i) { const int id = (tid + 512 * i) % 1664; const int s = id / 26, j = id % 26; srow[i] = s;
        if (j < 6) { soff[i] = PC_GQ + h * 48 + 8 * j; doff[i] = GL_RQ + s * 96 + 16 * j; }
        else if (j < 12) { soff[i] = PC_GK + h * 48 + 8 * (j - 6); doff[i] = GL_RK + s * 96 + 16 * (j - 6); }
        else if (j < 24) { soff[i] = PC_GV + h * 96 + 8 * (j - 12); doff[i] = GL_RV + s * GL_VSTR + 16 * (j - 12); }
        else { soff[i] = PC_GLF + dir * 16 + 8 * (j - 24); doff[i] = GL_RG + s * 32 + 16 * (j - 24); } }
    v4u pre[4];
#define GLA_LOAD(c) do { _Pragma("unroll") for (int i = 0; i < 4; ++i) { const int pi = 64 * (c) + srow[i]; const int tok = tokbase + (dir ? N - 1 - pi : pi); pre[i] = *(const v4u*)(P + (size_t)tok * PCOLS + soff[i]); } } while (0)
    GLA_LOAD(0);
    const int d = tid % 48, sg = tid / 48;
    float wgr[16]; float bgd = 0.f;
    if (tid < 384) { const float* wg = F.in[dir ? I_WGB : I_WGF] + l * 16 * 192 + h * 48 + d; bgd = F.in[dir ? I_BGB : I_BGF][l * 192 + h * 48 + d];
#pragma unroll
        for (int q = 0; q < 16; ++q) wgr[q] = wg[q * 192]; }
    else {
#pragma unroll
        for (int q = 0; q < 16; ++q) wgr[q] = 0.f; }
    __syncthreads();
    for (int i = tid; i < (64 + 64 + 96) * 12; i += NTHR) { const int row = i / 12, c = i % 12; LAS unsigned char* base = row < 64 ? QE + row * GL_STR : (row < 128 ? KE + (row - 64) * GL_STR : ST + (row - 128) * GL_STR);
        *(LAS unsigned*)(base + 96 + c * 4) = 0u; }
    f32x4 S[3];
#pragma unroll
    for (int dt = 0; dt < 3; ++dt) S[dt] = (f32x4){0.f, 0.f, 0.f, 0.f};
    if (lat && w < 6) { const float* s0 = F.in[dir ? I_SB : I_SF] + (size_t)((b * 2 + l) * 4 + h) * 4608;
#pragma unroll
        for (int dt = 0; dt < 3; ++dt)
#pragma unroll
            for (int j = 0; j < 4; ++j) S[dt][j] = s0[(16 * dt + 4 * g + j) * 96 + 16 * w + r]; }
    for (int c = 0; c < nc; ++c) {
        __syncthreads();
        if (w < 6) {
#pragma unroll
            for (int dt = 0; dt < 3; ++dt) { v2u o; o.x = pk2(S[dt][0], S[dt][1]); o.y = pk2(S[dt][2], S[dt][3]); *(LAS v2u*)(ST + (16 * w + r) * GL_STR + (16 * dt + 4 * g) * 2) = o; }
        }
#pragma unroll
        for (int i = 0; i < 4; ++i) if (i < 3 || tid < 128) *(LAS v4u*)(L + doff[i]) = pre[i];
        __syncthreads();
        if (c + 1 < nc) GLA_LOAD(c + 1);
        float pfx[8];
        if (tid < 384) {
#pragma unroll
            for (int i = 0; i < 8; ++i) { const LAS unsigned* gp = (const LAS unsigned*)(L + GL_RG + (8 * sg + i) * 32); float x = bgd;
#pragma unroll
                for (int q = 0; q < 8; ++q) { const unsigned wv = gp[q]; x += bflo(wv) * wgr[2 * q] + bfhi(wv) * wgr[2 * q + 1]; }
                const float ls = (fminf(x, 0.f) - log1pf(__expf(-fabsf(x)))) * (1.0f / 16.0f);
                pfx[i] = i == 0 ? ls : pfx[i - 1] + ls; }
            T[sg * 48 + d] = pfx[7];
        }
        __syncthreads();
        if (tid < 384) {
            float off = 0.f, tot = 0.f;
#pragma unroll
            for (int q = 0; q < 8; ++q) { const float t = T[q * 48 + d]; tot += t; off += q < sg ? t : 0.f; }
            if (sg == 0) BL[d] = tot;
            unsigned kd[4]; float kdv[8];
#pragma unroll
            for (int i = 0; i < 8; ++i) { const int s = 8 * sg + i; const float bc = pfx[i] + off;
                const float qv = bf2f(*(const LAS bf16*)(L + GL_RQ + s * 96 + d * 2)) * 0.14433756729740643f, kv = bf2f(*(const LAS bf16*)(L + GL_RK + s * 96 + d * 2));
                *(LAS bf16*)(QE + s * GL_STR + d * 2) = f2bf(qv * __expf(bc)); *(LAS bf16*)(KE + s * GL_STR + d * 2) = f2bf(kv * __expf(-bc)); kdv[i] = kv * __expf(tot - bc); }
#pragma unroll
            for (int i = 0; i < 4; ++i) kd[i] = pk2(kdv[2 * i], kdv[2 * i + 1]);
            *(LAS v4u*)(KDT + d * GL_STR + sg * 16) = (v4u){kd[0], kd[1], kd[2], kd[3]};
        }
        __syncthreads();
#pragma unroll
        for (int tl = 0; tl < 2; ++tl) { const int tile = 2 * w + tl, ti = tile >> 2, si = tile & 3; f32x4 cc = (f32x4){0.f, 0.f, 0.f, 0.f};
            if (si <= ti) {
#pragma unroll
                for (int ks = 0; ks < 2; ++ks) { const bf16x8 a = *(LAS const bf16x8*)(KE + (16 * si + r) * GL_STR + (32 * ks + 8 * g) * 2); const bf16x8 bq = *(LAS const bf16x8*)(QE + (16 * ti + r) * GL_STR + (32 * ks + 8 * g) * 2); cc = mfma16(a, bq, cc); }
            }
            const int tq = 16 * ti + r; float o[4];
#pragma unroll
            for (int j = 0; j < 4; ++j) o[j] = (16 * si + 4 * g + j <= tq) ? cc[j] : 0.f;
            v2u ow; ow.x = pk2(o[0], o[1]); ow.y = pk2(o[2], o[3]); *(LAS v2u*)(AT + tq * GL_STR + (16 * si + 4 * g) * 2) = ow; }
        if (w < 6) {
            bf16x8 bv[2];
#pragma unroll
            for (int ks = 0; ks < 2; ++ks) { LAS const unsigned char* vp = RV + (32 * ks + 8 * g + (r >> 2)) * GL_VSTR + (16 * w + 4 * (r & 3)) * 2; const s16x4 lo = vtr(vp), hi = vtr(vp + 4 * GL_VSTR);
                bv[ks] = (bf16x8){lo[0], lo[1], lo[2], lo[3], hi[0], hi[1], hi[2], hi[3]}; }
#pragma unroll
            for (int dt = 0; dt < 3; ++dt) { f32x4 u = (f32x4){0.f, 0.f, 0.f, 0.f};
#pragma unroll
                for (int ks = 0; ks < 2; ++ks) { const bf16x8 a = *(LAS const bf16x8*)(KDT + (16 * dt + r) * GL_STR + (32 * ks + 8 * g) * 2); u = mfma16(a, bv[ks], u); }
#pragma unroll
                for (int j = 0; j < 4; ++j) S[dt][j] = __expf(BL[16 * dt + 4 * g + j]) * S[dt][j] + u[j]; }
        } else {
        }
        __syncthreads();
#pragma unroll
        for (int tl = 0; tl < 3; ++tl) { const int tile = w + 8 * tl, ti = tile / 6, vi = tile % 6; f32x4 cc = (f32x4){0.f, 0.f, 0.f, 0.f};
#pragma unroll
            for (int ks = 0; ks < 2; ++ks) { LAS const unsigned char* vp = RV + (32 * ks + 8 * g + (r >> 2)) * GL_VSTR + (16 * vi + 4 * (r & 3)) * 2; const s16x4 lo = vtr(vp), hi = vtr(vp + 4 * GL_VSTR);
                const bf16x8 a = {lo[0], lo[1], lo[2], lo[3], hi[0], hi[1], hi[2], hi[3]};
                const bf16x8 bq = *(LAS const bf16x8*)(AT + (16 * ti + r) * GL_STR + (32 * ks + 8 * g) * 2); cc = mfma16(a, bq, cc); }
#pragma unroll
            for (int ks = 0; ks < 2; ++ks) { const bf16x8 a = *(LAS const bf16x8*)(ST + (16 * vi + r) * GL_STR + (32 * ks + 8 * g) * 2); const bf16x8 bq = *(LAS const bf16x8*)(QE + (16 * ti + r) * GL_STR + (32 * ks + 8 * g) * 2); cc = mfma16(a, bq, cc); }
            const int pi = 64 * c + 16 * ti + r; const int tok = tokbase + (dir ? N - 1 - pi : pi);
            v2u ow; ow.x = pk2(cc[0], cc[1]); ow.y = pk2(cc[2], cc[3]);
            bf16* dst = dir ? OCB + (size_t)tok * 384 + h * 96 + 16 * vi + 4 * g : MIX + (size_t)tok * 1024 + 640 + h * 96 + 16 * vi + 4 * g;
            *(v2u*)dst = ow; }
    }
#undef GLA_LOAD
    if (!lat && w < 6) { float* so = F.out + (dir ? O_SB : O_SF) + (size_t)((b * 2 + l) * 4 + h) * 4608;
#pragma unroll
        for (int dt = 0; dt < 3; ++dt)
#pragma unroll
            for (int j = 0; j < 4; ++j) so[(16 * dt + 4 * g + j) * 96 + 16 * w + r] = S[dt][j]; }
}

constexpr int NU_GL = 64, NU_ML = 384, NU_DL = 256, NU_GC = 256, NU_MC = 384, NU_DC = 256, NU_ALL = NU_GL + NU_ML + NU_DL + NU_GC + NU_MC + NU_DC;
__device__ __forceinline__ void mixer_phase(Frame& F, int l, int rep) {
    LAS int* us = (LAS int*)(F.lds + 140000);
    unsigned* ctr = (unsigned*)(F.ws + WS_CTL) + 64 * l + 256 * rep;
    for (;;) {
        __syncthreads();
        if (F.tid == 0) *us = (int)atomicAdd(ctr, 1u);
        __syncthreads();
        int u = *us; if (u >= NU_ALL) break;
        int type, lat, b, h, x;
        if (u < NU_GL) { type = 0; lat = 1; b = u >> 3; h = (u >> 1) & 3; x = u & 1; }
        else if ((u -= NU_GL) < NU_ML) { type = 1; lat = 1; b = u / 48; const int rr = u % 48; h = rr >> 3; x = rr & 7; }
        else if ((u -= NU_ML) < NU_DL) { type = 2; lat = 1; b = u >> 5; const int rr = u & 31; h = rr >> 3; x = rr & 7; }
        else if ((u -= NU_DL) < NU_GC) { type = 0; lat = 0; b = u >> 3; h = (u >> 1) & 3; x = u & 1; }
        else if ((u -= NU_GC) < NU_MC) { type = 1; lat = 0; b = u / 12; const int rr = u % 12; h = rr >> 1; x = rr & 1; }
        else { u -= NU_MC; type = 2; lat = 0; b = u >> 3; const int rr = u & 7; h = rr >> 1; x = rr & 1; }
        Frame F2 = F; { int t = F.tid; asm volatile("" : "+v"(t)); F2.tid = t; F2.lane = t & 63; F2.wave = __builtin_amdgcn_readfirstlane(t >> 6);
            unsigned char* w2 = F.ws; asm volatile("" : "+s"(w2)); F2.ws = w2; }
        if (type == 0) gla_unit(F2, l, lat != 0, b, h, x);
        else if (type == 1) mla_unit(F2, l, lat != 0, b, h, x);
        else diff_unit(F2, l, lat != 0, b, h, x);
    }
}

__device__ __forceinline__ void merge_phase(Frame& F, int l) {
    unsigned char* ws = F.ws; bf16* MIX = (bf16*)(ws + WS_U); const bf16* OCB = (const bf16*)(ws + WS_OCB); const bf16* P = (const bf16*)(ws + WS_PH);
    const float* on = F.in[I_ONORM] + l * 384; const float* dn = F.in[I_DNORM] + l * 64; const float* gn = F.in[I_GNORM] + l * 96;
    const float oml = 1.0f - (l == 0 ? 0.2f : (0.8f - 0.6f * 0.7408182206817179f));
    const int lane = F.lane;
    for (int m = F.gw; m < MTOK; m += F.ngw) {
        bf16* row = MIX + (size_t)m * 1024;
        unsigned wa[3], wb[2], wc[3], wd[3], wr_[3];
#pragma unroll
        for (int j = 0; j < 3; ++j) { wa[j] = *(const unsigned*)(row + lane * 6 + 2 * j); wc[j] = *(const unsigned*)(row + 640 + lane * 6 + 2 * j); wd[j] = *(const unsigned*)(OCB + (size_t)m * 384 + lane * 6 + 2 * j);
            wr_[j] = *(const unsigned*)(P + (size_t)m * PCOLS + PC_RC + lane * 6 + 2 * j); }
        { const v2u t = *(const v2u*)(row + 384 + lane * 4); wb[0] = t.x; wb[1] = t.y; }
        float xa[6], xb[4], xc[6]; float sa = 0.f, sb = 0.f, sc = 0.f;
#pragma unroll
        for (int j = 0; j < 3; ++j) { xa[2 * j] = bflo(wa[j]); xa[2 * j + 1] = bfhi(wa[j]); xc[2 * j] = bflo(wc[j]) + bflo(wd[j]); xc[2 * j + 1] = bfhi(wc[j]) + bfhi(wd[j]); }
#pragma unroll
        for (int j = 0; j < 2; ++j) { xb[2 * j] = bflo(wb[j]); xb[2 * j + 1] = bfhi(wb[j]); }
#pragma unroll
        for (int e = 0; e < 6; ++e) { sa += xa[e] * xa[e]; sc += xc[e] * xc[e]; }
#pragma unroll
        for (int e = 0; e < 4; ++e) sb += xb[e] * xb[e];
        const float ra = rsqrtf(wave_sum(sa) * (1.0f / 384.0f) + EPS), rb = rsqrtf(grp16_sum(sb) * (1.0f / 64.0f) + EPS) * oml, rc = rsqrtf(grp16_sum(sc) * (1.0f / 96.0f) + EPS);
        float ya[6], yb[4], yc[6];
#pragma unroll
        for (int e = 0; e < 6; ++e) { ya[e] = xa[e] * ra * on[lane * 6 + e];
            const float rv = (e & 1) ? bfhi(wr_[e >> 1]) : bflo(wr_[e >> 1]); const float sg = rv / (1.0f + __expf(-rv));
            yc[e] = xc[e] * rc * gn[(lane & 15) * 6 + e] * sg; }
#pragma unroll
        for (int e = 0; e < 4; ++e) yb[e] = xb[e] * rb * dn[(lane & 15) * 4 + e];
#pragma unroll
        for (int j = 0; j < 3; ++j) { *(unsigned*)(row + lane * 6 + 2 * j) = pk2(ya[2 * j], ya[2 * j + 1]); *(unsigned*)(row + 640 + lane * 6 + 2 * j) = pk2(yc[2 * j], yc[2 * j + 1]); }
        { v2u o; o.x = pk2(yb[0], yb[1]); o.y = pk2(yb[2], yb[3]); *(v2u*)(row + 384 + lane * 4) = o; }
    }
}

#define RLX_AGENT __ATOMIC_RELAXED, __HIP_MEMORY_SCOPE_AGENT
#define XB_TMO      128
#define XB_XCNT(j)  (256  + 64 * (j))
#define XB_XSUB(j)  (1280 + 64 * (j))
#define XB_XGEN(j)  (2304 + 64 * (j))
#define XB_TOP      3328
#define XB_TOPGEN   3392
#define XCD_BAR_WORDS 3456
#define XB_SPIN_CAP (1u << 18)

__device__ __forceinline__ unsigned xb_ld(unsigned* p)              { return __hip_atomic_load(p, __ATOMIC_RELAXED, __HIP_MEMORY_SCOPE_AGENT); }
__device__ __forceinline__ unsigned xb_add(unsigned* p, unsigned v) { return __hip_atomic_fetch_add(p, v, __ATOMIC_RELAXED, __HIP_MEMORY_SCOPE_AGENT); }
__device__ __forceinline__ unsigned xb_xcc_id() { return (unsigned)__builtin_amdgcn_s_getreg((3 << 11) | 20) & 0xFu; }
#define XB_SPIN(cond, bar) do { unsigned _sp = 0; while (cond) { __builtin_amdgcn_s_sleep(1); \
    if ((++_sp & 255u) == 0u) { if (xb_ld(&(bar)[XB_TMO])) break; if (_sp > XB_SPIN_CAP) { atomicAdd(&(bar)[XB_TMO], 1u); break; } } } } while (0)

struct XcdBarrier {
    unsigned* bar; unsigned x;
    volatile LAS unsigned* st;
};

__device__ __forceinline__ XcdBarrier xcd_barrier_post(unsigned* bar, volatile LAS unsigned* st) {
    XcdBarrier b; b.bar = bar; b.x = xb_xcc_id(); b.st = st;
    if (threadIdx.x == 0) (void)xb_add(&bar[XB_XCNT(b.x)], 1u);
    return b;
}
__device__ __forceinline__ void xcd_barrier_complete(unsigned* bar, unsigned x, unsigned& nloc, unsigned& nx) {
    const unsigned G = gridDim.x * gridDim.y * gridDim.z;
    unsigned sum, cnt, mine, sp = 0u;
    for (;;) {
        sum = 0u; cnt = 0u; mine = 0u;
#pragma unroll
        for (unsigned j = 0; j < 16; ++j) { const unsigned c = xb_ld(&bar[XB_XCNT(j)]); sum += c; cnt += (c > 0u) ? 1u : 0u; mine = (j == x) ? c : mine; }
        if (sum == G) break;
        __builtin_amdgcn_s_sleep(1);
        if ((++sp & 255u) == 0u) { if (xb_ld(&bar[XB_TMO])) break; if (sp > XB_SPIN_CAP) { atomicAdd(&bar[XB_TMO], 1u); break; } }
    }
    nloc = mine > 0u ? mine : 1u; nx = cnt > 0u ? cnt : 1u;
}

__device__ __forceinline__ void xcd_barrier(const XcdBarrier& b) {
    asm volatile("s_waitcnt vmcnt(0)" ::: "memory");
    __syncthreads();
    if (threadIdx.x == 0) {
        unsigned* bar = b.bar;
        __builtin_amdgcn_s_waitcnt(0);
        unsigned nloc = b.st[0], nx = b.st[1];
        if (nloc == 0u) { xcd_barrier_complete(bar, b.x, nloc, nx); b.st[0] = nloc; b.st[1] = nx; }
        const unsigned old = xb_add(&bar[XB_XSUB(b.x)], 1u);
        const unsigned gen = old / nloc;
        if (old + 1u == (gen + 1u) * nloc) {
            __builtin_amdgcn_fence(__ATOMIC_RELEASE, "agent");
            asm volatile("s_waitcnt vmcnt(0)" ::: "memory");
            const unsigned og = xb_add(&bar[XB_TOP], 1u);
            const unsigned tg = og / nx;
            if (og + 1u == (tg + 1u) * nx) xb_add(&bar[XB_TOPGEN], 1u);
            else XB_SPIN(xb_ld(&bar[XB_TOPGEN]) == tg, bar);
            __builtin_amdgcn_fence(__ATOMIC_ACQUIRE, "agent");
            xb_add(&bar[XB_XGEN(b.x)], 1u);
            asm volatile("s_waitcnt vmcnt(0)" ::: "memory");
        } else {
            XB_SPIN(xb_ld(&bar[XB_XGEN(b.x)]) == gen, bar);
            __builtin_amdgcn_fence(__ATOMIC_ACQUIRE, "agent");
            asm volatile("s_waitcnt vmcnt(0)" ::: "memory");
        }
    }
    __syncthreads();
}

__global__ void __launch_bounds__(NTHR, 2) mega_fwd(Args args) {
    extern __shared__ __attribute__((aligned(16))) unsigned char lds_raw[];
    cg::grid_group grid = cg::this_grid();
    Frame F;
    F.lds = (LAS unsigned char*)lds_raw;
    F.tid = threadIdx.x; F.lane = F.tid & 63; F.wave = __builtin_amdgcn_readfirstlane(F.tid >> 6);
    F.G = gridDim.x; F.gw = blockIdx.x * NWAVES + F.wave; F.ngw = F.G * NWAVES;
    inptr_t kin = (inptr_t)__builtin_amdgcn_kernarg_segment_ptr();
    asm volatile("" : "+s"(kin));
    F.in = kin; F.out = (float*)kin[N_IN]; F.ws = (unsigned char*)kin[N_IN + 1];
    unsigned char* ws = F.ws;
    float* X = F.out + O_X;
    volatile LAS unsigned* bst = (volatile LAS unsigned*)(F.lds + 140032);
    if (F.tid < 2) bst[F.tid] = 0u;
    __syncthreads();
    XcdBarrier xbar = xcd_barrier_post((unsigned*)(ws + WS_CTL + 65536), bst);
    bf16* U = (bf16*)(ws + WS_U); bf16* PH = (bf16*)(ws + WS_PH);
    const float* MOD = (const float*)(ws + WS_MOD);
    const int bx = (int)blockIdx.x;

#pragma unroll 1
    for (int st = 0; st < 28; ++st) {
        const int l = st / 14, k = st % 14;
        { int t = threadIdx.x; asm volatile("" : "+v"(t)); F.tid = t; F.lane = t & 63; F.wave = __builtin_amdgcn_readfirstlane(t >> 6); F.gw = blockIdx.x * NWAVES + F.wave;
          asm volatile("" : "+s"(kin)); F.in = kin; F.out = (float*)kin[N_IN]; X = F.out + O_X;
          unsigned char* w2 = (unsigned char*)kin[N_IN + 1]; asm volatile("" : "+s"(w2)); F.ws = w2; ws = w2; U = (bf16*)(ws + WS_U); PH = (bf16*)(ws + WS_PH); MOD = (const float*)(ws + WS_MOD); }
        const float* modl = MOD + (size_t)l * 9 * 9216;
        const bool first = (l == 0 && k <= 3);
        const float* xc = first ? F.in[I_XP] : X; const float* xl = first ? F.in[I_XS] : X + (size_t)MCTX * D;
        if (k == 0) { prep_phase(F, l); }
        else if (k == 1 || k == 4 || k == 11) { const int ni = k == 1 ? 0 : (k == 4 ? 1 : 2);
            norm_phase(F, xc, xl, F.in[k == 1 ? I_NF1 : (k == 4 ? I_NMIX : I_NF2)] + l * D, modl, ni, U); }
        else if (k == 2 || k == 12) {
#if PROBE_G13
#pragma unroll 1
          for (int rep = 0; rep < 2; ++rep) {
#else
          {
#endif
            pg8::Gemm g{U, (const bf16*)(ws + (k == 2 ? WS_WT13A : WS_WT13B)), MTOK, 2 * DFF, D}; pg8::StaticOrder S; S.init(MTOK, 2 * DFF, F.G, bx); pg8::EpiSwiglu E{PH, DFF};
            pg8::gemm_phase<pg8::EpiSwiglu, pg8::StaticOrder, true, true>(F.lds, g, S, E); } }
        else if (k == 3 || k == 10 || k == 13) {
            const bf16* A = k == 10 ? U : PH; const bf16* Bt = (const bf16*)(ws + (k == 3 ? WS_WT2A : (k == 10 ? WS_WTOUT : WS_WT2B))); const int K = k == 10 ? D : DFF;
            const int gi = k == 3 ? 2 : (k == 10 ? 5 : 8); const float gs = k == 10 ? 1.0f : 0.5f;
            pg8::Gemm g{A, Bt, MTOK, D, K}; pg8::StaticOrder S; S.init(MTOK, D, F.G, bx); pg8::EpiResid E{xc, xl, X, modl + gi * 1024, gs};
            pg8::gemm_phase<pg8::EpiResid, pg8::StaticOrder, true, true>(F.lds, g, S, E); }
        else if (k == 5 || k == 7) {
            const int nj = k == 7 ? 2 : 1;
#pragma unroll 1
            for (int j = 0; j < nj; ++j) {
                const bf16* A = k == 5 ? U : (const bf16*)(ws + (j == 0 ? WS_CQN : WS_CKV)); const bf16* Bt = (const bf16*)(ws + (k == 5 ? WS_WTIN : (j == 0 ? WS_WTUQ : WS_WTUKV)));
                bf16* O = k == 5 ? PH : (bf16*)(ws + (j == 0 ? WS_QA : WS_KNV));
                const int M = (k == 7 && j == 1) ? NKEYROWS : MTOK, N = k == 5 ? PCOLS : 768, K = k == 5 ? D : (j == 0 ? 384 : 256);
                pg8::Gemm g{A, Bt, M, N, K}; pg8::StaticOrder S; S.init(M, N, F.G, (bx + 64 * j) % F.G); pg8::EpiBf16P E{O, N};
                pg8::gemm_phase<pg8::EpiBf16P, pg8::StaticOrder, true, true>(F.lds, g, S, E); } }
        else if (k == 6) postproj_phase(F, l);
        else if (k == 8) { mixer_phase(F, l, 0);
#if PROBE_MIXER2
            xcd_barrier(xbar); mixer_phase(F, l, 1);
#endif
        }
        else merge_phase(F, l);
        if (st == 0) grid.sync(); else xcd_barrier(xbar);
#if PROBE_BAR2
        if (k == 8) xcd_barrier(xbar);
#endif
    }
    final_norm_phase(F, X, F.in[I_FNORM]);
}

extern "C" void kernel_launch(void* const* d_in, const int* in_sizes, int n_in, void* d_out, int out_size, void* d_ws, size_t ws_size, hipStream_t stream) {
    static int grid = 0;
    if (grid == 0) {
        if (n_in != N_IN || ws_size < WS_END) { fprintf(stderr, "kernel_launch: unexpected n_in %d or ws_size %zu\n", n_in, ws_size); grid = -1; return; }
        int dev = 0, cus = 0, per_cu = 0;
        (void)hipGetDevice(&dev); (void)hipDeviceGetAttribute(&cus, hipDeviceAttributeMultiprocessorCount, dev);
        if (hipFuncSetAttribute((const void*)mega_fwd, hipFuncAttributeMaxDynamicSharedMemorySize, LDS_BYTES) != hipSuccess) fprintf(stderr, "kernel_launch: hipFuncSetAttribute failed\n");
        if (hipOccupancyMaxActiveBlocksPerMultiprocessor(&per_cu, (const void*)mega_fwd, NTHR, LDS_BYTES) != hipSuccess || per_cu < 1) { fprintf(stderr, "kernel_launch: occupancy query gave %d\n", per_cu); per_cu = 1; }
        (void)hipGetLastError();
        grid = cus * per_cu;
    }
    if (grid < 0) return;
    (void)hipMemsetAsync((char*)d_ws + WS_CTL, 0, 131072, stream);
    Args a{};
    for (int i = 0; i < N_IN; ++i) a.in[i] = (const float*)d_in[i];
    a.out = (float*)d_out; a.ws = (unsigned char*)d_ws;
    void* kargs[] = {&a};
    hipError_t e = hipLaunchCooperativeKernel((const void*)mega_fwd, dim3(grid), dim3(NTHR), kargs, LDS_BYTES, stream);
    if (e != hipSuccess) fprintf(stderr, "kernel_launch: cooperative launch failed: %s (grid %d)\n", hipGetErrorString(e), grid);
}
```
